# Optimizing an MI355X kernel written in HIP

```python
import jax, jax.numpy as jnp
from jax import lax
import numpy as np

D_MODEL = 1024
BATCH = 2
SEQ = 8192
DEPTH = 1

HEAD_DIM = 64
SB_HEADS = 8
DIL_GROUPS = ((128, 1), (512, 4), (2048, 16))
DIL_KV_HEADS = 4
DIL_Q_HEADS = DIL_KV_HEADS * len(DIL_GROUPS)
D_FF = 2816
ROPE_THETA = 10000.0
RMS_EPS = 1e-6
Q_BLOCK = 128

SB_W = SB_HEADS * HEAD_DIM
DQ_W = DIL_Q_HEADS * HEAD_DIM
DKV_W = DIL_KV_HEADS * HEAD_DIM
IN_SIZES = (SB_W, SB_W, SB_W, DQ_W, DKV_W, DKV_W, 2 * D_MODEL)
IN_WIDTH = SB_W * 3 + DQ_W + 2 * DKV_W + 2 * D_MODEL

kernel_name = "hybrid_stickbreak_dilated_macaron"


def rmsnorm(x, g):
    xf = x.astype(jnp.float32)
    y = xf * lax.rsqrt(jnp.mean(xf * xf, axis=-1, keepdims=True) + RMS_EPS)
    return (y * g.astype(jnp.float32)).astype(x.dtype)


def swiglu(h, w1, w3, w2):
    return (jax.nn.silu(h @ w1) * (h @ w3)) @ w2


def split_heads(t, n):
    b, s, _ = t.shape
    return t.reshape(b, s, n, HEAD_DIM).transpose(0, 2, 1, 3)


def merge_heads(t):
    b, h, s, dh = t.shape
    return t.transpose(0, 2, 1, 3).reshape(b, s, h * dh)


def rope(t):
    s, dh = t.shape[2], t.shape[3]
    half = dh // 2
    inv_freq = ROPE_THETA ** (-jnp.arange(half, dtype=jnp.float32) / half)
    ang = jnp.arange(s, dtype=jnp.float32)[:, None] * inv_freq[None, :]
    cos, sin = jnp.cos(ang), jnp.sin(ang)
    tf = t.astype(jnp.float32)
    t1, t2 = tf[..., :half], tf[..., half:]
    out = jnp.concatenate([t1 * cos - t2 * sin, t2 * cos + t1 * sin], axis=-1)
    return out.astype(t.dtype)


def stick_breaking_attention(q, k, v):
    s_len = q.shape[2]
    scale = HEAD_DIM ** -0.5
    outs = []
    for i in range(s_len // Q_BLOCK):
        t0, end = i * Q_BLOCK, (i + 1) * Q_BLOCK
        qb, kb, vb = q[:, :, t0:end], k[:, :, :end], v[:, :, :end]
        z = jnp.einsum('bhqd,bhkd->bhqk', qb, kb).astype(jnp.float32) * scale
        t_pos = t0 + jnp.arange(Q_BLOCK)[:, None]
        s_pos = jnp.arange(end)[None, :]
        strict = s_pos < t_pos
        log_not = jnp.where(strict, jax.nn.log_sigmoid(-z), 0.0)
        between = lax.cumsum(log_not, axis=3, reverse=True) - log_not
        a = jnp.where(strict, jnp.exp(jax.nn.log_sigmoid(z) + between), 0.0)
        outs.append(jnp.einsum('bhqk,bhkd->bhqd', a.astype(vb.dtype), vb))
    return jnp.concatenate(outs, axis=2)


def dilated_window_attention(q, k, v):
    b, _, s_len, dh = q.shape
    n_groups = len(DIL_GROUPS)
    nb = s_len // Q_BLOCK
    scale = HEAD_DIM ** -0.5
    qg = q.reshape(b, n_groups, DIL_KV_HEADS, nb, Q_BLOCK, dh).transpose(3, 1, 0, 2, 4, 5)

    def block(args):
        qblk, t0 = args
        t_pos = t0 + jnp.arange(Q_BLOCK)
        outs, lses = [], []
        for g, (window, dil) in enumerate(DIL_GROUPS):
            m = jnp.arange(window // dil + 1)
            idx = t_pos[:, None] - dil * m[None, :]
            valid = idx >= 0
            idx = jnp.maximum(idx, 0)
            kg = jnp.take(k, idx, axis=2)
            vg = jnp.take(v, idx, axis=2)
            sc = jnp.einsum('bhqd,bhqmd->bhqm', qblk[g], kg).astype(jnp.float32) * scale
            sc = jnp.where(valid, sc, -jnp.inf)
            mx = jnp.max(sc, axis=-1, keepdims=True)
            e = jnp.exp(sc - mx)
            den = jnp.sum(e, axis=-1, keepdims=True)
            p = e / den
            outs.append(jnp.einsum('bhqm,bhqmd->bhqd', p.astype(vg.dtype), vg).astype(jnp.float32))
            lses.append(mx + jnp.log(den))
        alpha = jax.nn.softmax(jnp.stack(lses), axis=0)
        return jnp.sum(alpha * jnp.stack(outs), axis=0).astype(v.dtype)

    t0s = jnp.arange(nb, dtype=jnp.int32) * Q_BLOCK
    o = lax.map(block, (qg, t0s))
    return o.transpose(1, 2, 0, 3, 4).reshape(b, DIL_KV_HEADS, s_len, dh)


def setup_inputs(seed: int = 0) -> dict:
    key = jax.random.key(seed)
    ks = jax.random.split(key, 20)

    def w(k, shape, fan_in):
        return jax.random.normal(k, shape, jnp.float32) * fan_in ** -0.5

    def gain(k, shape):
        return 1.0 + 0.05 * jax.random.normal(k, shape, jnp.float32)

    L = DEPTH
    return {
        "x": jax.random.normal(ks[0], (BATCH, SEQ, D_MODEL), jnp.float32),
        "g_ffn1": gain(ks[1], (L, D_MODEL)),
        "w1_a": w(ks[2], (L, D_MODEL, D_FF), D_MODEL),
        "w3_a": w(ks[3], (L, D_MODEL, D_FF), D_MODEL),
        "w2_a": w(ks[4], (L, D_FF, D_MODEL), D_FF),
        "g_mix": gain(ks[5], (L, D_MODEL)),
        "w_in": w(ks[6], (L, D_MODEL, IN_WIDTH), D_MODEL),
        "b_gate": 0.01 * jax.random.normal(ks[7], (L, 2 * D_MODEL), jnp.float32),
        "w_sb_out": w(ks[8], (L, SB_W, D_MODEL), SB_W),
        "w_dil_out": w(ks[9], (L, DKV_W, D_MODEL), DKV_W),
        "w_o": w(ks[10], (L, D_MODEL, D_MODEL), D_MODEL),
        "g_ffn2": gain(ks[11], (L, D_MODEL)),
        "w1_b": w(ks[12], (L, D_MODEL, D_FF), D_MODEL),
        "w3_b": w(ks[13], (L, D_MODEL, D_FF), D_MODEL),
        "w2_b": w(ks[14], (L, D_FF, D_MODEL), D_FF),
        "g_final": gain(ks[15], (D_MODEL,)),
    }


def reference(x, g_ffn1, w1_a, w3_a, w2_a, g_mix, w_in, b_gate, w_sb_out, w_dil_out, w_o,
              g_ffn2, w1_b, w3_b, w2_b, g_final):
    split_points = [int(p) for p in np.cumsum(IN_SIZES)[:-1]]
    for l in range(DEPTH):
        h = rmsnorm(x, g_ffn1[l])
        x = x + 0.5 * swiglu(h, w1_a[l], w3_a[l], w2_a[l])

        h = rmsnorm(x, g_mix[l])
        proj = h @ w_in[l]
        q_sb, k_sb, v_sb, q_dl, k_dl, v_dl, gate_pre = jnp.split(proj, split_points, axis=-1)
        gates = jax.nn.sigmoid(gate_pre + b_gate[l])
        g_sb, g_dl = gates[..., :D_MODEL], gates[..., D_MODEL:]

        y_sb = stick_breaking_attention(split_heads(q_sb, SB_HEADS), split_heads(k_sb, SB_HEADS),
                                        split_heads(v_sb, SB_HEADS))
        y_sb = merge_heads(y_sb) @ w_sb_out[l]

        y_dl = dilated_window_attention(rope(split_heads(q_dl, DIL_Q_HEADS)),
                                        rope(split_heads(k_dl, DIL_KV_HEADS)),
                                        split_heads(v_dl, DIL_KV_HEADS))
        y_dl = merge_heads(y_dl) @ w_dil_out[l]

        x = x + (g_sb * y_sb + g_dl * y_dl) @ w_o[l]

        h = rmsnorm(x, g_ffn2[l])
        x = x + 0.5 * swiglu(h, w1_b[l], w3_b[l], w2_b[l])
    return rmsnorm(x, g_final)
```

```cpp
#include <hip/hip_runtime.h>
#include <hip/hip_cooperative_groups.h>
#include <cstdio>
#include <cstdint>
namespace cg = cooperative_groups;

constexpr int MTOK = 16384, SEQ = 8192, DMODEL = 1024, DFF = 2816, SBW = 512, DQW = 768, DKVW = 256, INW = 4864;
constexpr float RMS_EPS = 1e-6f;
constexpr float LOG2E = 1.4426950408889634f;
constexpr float QSCALE = 0.125f * 1.4426950408889634f;

constexpr size_t WSO_ROPE = 46u << 20, WSO_RSS = 48u << 20, WSO_QSB = 89u << 20, WSO_KSB = 105u << 20, WSO_VSB = 121u << 20, WSO_QDL = 137u << 20, WSO_KDL = 161u << 20, WSO_VDL = 169u << 20, WSO_GATES = 177u << 20;
namespace pg8 {
#define PG8_LAS __attribute__((address_space(3)))
typedef unsigned short bf16_t;
typedef short bf16x8 __attribute__((ext_vector_type(8)));
typedef float f32x4 __attribute__((ext_vector_type(4)));
typedef unsigned u32x4 __attribute__((ext_vector_type(4)));
constexpr int BM = 256, BK = 64, HALF = 128, HTB = HALF * BK * 2  , STAGE_BYTES = 8 * HTB, NXCD = 8, WGM = 8;

__host__ __device__ __forceinline__ int lds_byte(int r, int c) { const int st = (r >> 4) * 2 + (c >> 5), rr = r & 15, cc = c & 31, ob = rr * 64 + cc * 2; return st * 1024 + (ob ^ (((ob >> 9) & 1) << 5)); }
__host__ __device__ __forceinline__ void stage_rc(int b, int& R, int& C) { const int st = b / 1024, sb = b % 1024, swz = sb ^ (((sb >> 9) & 1) << 5); R = (st >> 1) * 16 + swz / 64; C = (st & 1) * 32 + (swz % 64) / 2; }
__host__ __device__ __forceinline__ int perm32(int rho) { const int n = rho >> 4, i = rho & 15; return 8 * (i >> 2) + 4 * n + (i & 3); }

struct Unit { int pm, pn; };
struct Gemm { const bf16_t* A; const bf16_t* Bt; int M, N, K; };

struct StaticOrder {
    int nM, nN, nwg, G, c;
    __host__ __device__ void init(int M, int N, int G_, int c_) { nM = M / BM; nN = N / BM; nwg = nM * nN; G = G_; c = c_; }
    __host__ __device__ bool next(int i, Unit& u) const {
        const long L = (long)i * G + c; if (L >= nwg) return false;
        int wgid = (int)L; { const int q = nwg / NXCD, r = nwg % NXCD, xcd = wgid % NXCD, off = wgid / NXCD; wgid = (xcd < r ? xcd * (q + 1) : r * (q + 1) + (xcd - r) * q) + off; }
        const int nig = WGM * nN, gid = wgid / nig, fm = gid * WGM, gsz = (nM - fm) < WGM ? (nM - fm) : WGM;
        u.pm = fm + ((wgid % nig) % gsz); u.pn = (wgid % nig) / gsz; return true;
    }
    __device__ __forceinline__ void a_ready(const Unit&) const {}
    __device__ __forceinline__ void done(const Unit&) const {}
};

__device__ __forceinline__ unsigned cvt_pk_bf16(float lo, float hi) { unsigned r; asm volatile("v_cvt_pk_bf16_f32 %0, %1, %2" : "=v"(r) : "v"(lo), "v"(hi)); return r; }
typedef float f32x2 __attribute__((ext_vector_type(2)));
__device__ __forceinline__ u32x4 pack8(const f32x4 a, const f32x4 b) { u32x4 w; w.x = cvt_pk_bf16(a[0], a[1]); w.y = cvt_pk_bf16(a[2], a[3]); w.z = cvt_pk_bf16(b[0], b[1]); w.w = cvt_pk_bf16(b[2], b[3]); return w; }
__device__ __forceinline__ float bf_lo(unsigned w) { return __builtin_bit_cast(float, w << 16); }
__device__ __forceinline__ float bf_hi(unsigned w) { return __builtin_bit_cast(float, w & 0xffff0000u); }
__device__ __forceinline__ void load_rstd(float (&rs)[2][4], const float* rowss, int pm, int wr, int fr, int fq) {
#pragma unroll
    for (int ai = 0; ai < 2; ++ai)
#pragma unroll
        for (int m = 0; m < 4; ++m) { const int row = pm * BM + ai * HALF + wr * 64 + m * 16 + fr;
            const f32x4 p = *(const f32x4*)(rowss + (size_t)row * 16 + fq * 4); float s = (p[0] + p[1]) + (p[2] + p[3]);
            s += __shfl_xor(s, 16); s += __shfl_xor(s, 32); rs[ai][m] = 1.0f / sqrtf(s * (1.0f / DMODEL) + RMS_EPS); }
}
struct EpiSwiglu {
    static constexpr bool PERM = true, AFTER_DRAIN = false;
    bf16_t* U; const float* rowss;
    __device__ __forceinline__ void operator()(const f32x4 (&acc)[2][2][4][2], const Unit& u, int wr, int wc, int fr, int fq) const {
        float rs[2][4]; load_rstd(rs, rowss, u.pm, wr, fr, fq);
        const int col0 = u.pn * 128 + wc * 32 + 8 * fq;
#pragma unroll
        for (int ai = 0; ai < 2; ++ai)
#pragma unroll
            for (int m = 0; m < 4; ++m) { const int row = u.pm * BM + ai * HALF + wr * 64 + m * 16 + fr; const float r = rs[ai][m]; f32x4 o[2];
#pragma unroll
                for (int n = 0; n < 2; ++n) { const f32x4 a = acc[ai][0][m][n] * r, b = acc[ai][1][m][n] * r;
#pragma unroll
                    for (int e = 0; e < 4; ++e) { const float sg = __builtin_amdgcn_rcpf(1.0f + __builtin_amdgcn_exp2f(-a[e] * LOG2E)); o[n][e] = a[e] * sg * b[e]; } }
                *(u32x4*)(U + (size_t)row * DFF + col0) = pack8(o[0], o[1]); }
    }
};
struct EpiResid {
    static constexpr bool PERM = true, AFTER_DRAIN = false;
    const float* res; float* out; bf16_t* xb; float* rowss; float scale;
    __device__ __forceinline__ void operator()(const f32x4 (&acc)[2][2][4][2], const Unit& u, int wr, int wc, int fr, int fq) const {
#pragma unroll
        for (int ai = 0; ai < 2; ++ai)
#pragma unroll
            for (int m = 0; m < 4; ++m) { const int row = u.pm * BM + ai * HALF + wr * 64 + m * 16 + fr; float ss = 0.f;
#pragma unroll
                for (int bj = 0; bj < 2; ++bj) { const size_t off = (size_t)row * DMODEL + u.pn * BM + bj * HALF + wc * 32 + 8 * fq;
                    const f32x4 r0 = *(const f32x4*)(res + off), r1 = *(const f32x4*)(res + off + 4);
                    const f32x4 o0 = r0 + acc[ai][bj][m][0] * scale, o1 = r1 + acc[ai][bj][m][1] * scale;
                    *(f32x4*)(out + off) = o0; *(f32x4*)(out + off + 4) = o1;
                    if (xb) *(u32x4*)(xb + off) = pack8(o0, o1);
                    ss += (o0[0] * o0[0] + o0[1] * o0[1]) + (o0[2] * o0[2] + o0[3] * o0[3]) + (o1[0] * o1[0] + o1[1] * o1[1]) + (o1[2] * o1[2] + o1[3] * o1[3]); }
                if (rowss) { ss += __shfl_xor(ss, 16); ss += __shfl_xor(ss, 32); if (fq == 0) rowss[(size_t)row * 16 + u.pn * 4 + wc] = ss; }
                asm volatile("" ::: "memory"); }
    }
};
struct EpiInProj {
    static constexpr bool PERM = true, AFTER_DRAIN = false;
    unsigned char* ws; const float* bgate;
    __device__ __forceinline__ void operator()(const f32x4 (&acc)[2][2][4][2], const Unit& u, int wr, int wc, int fr, int fq) const {
        float rs[2][4]; load_rstd(rs, (const float*)(ws + WSO_RSS), u.pm, wr, fr, fq);
        const int pn = u.pn;
        bf16_t *qsb = (bf16_t*)(ws + WSO_QSB), *ksb = (bf16_t*)(ws + WSO_KSB), *vsb = (bf16_t*)(ws + WSO_VSB), *qdl = (bf16_t*)(ws + WSO_QDL), *kdl = (bf16_t*)(ws + WSO_KDL), *vdl = (bf16_t*)(ws + WSO_VDL), *gates = (bf16_t*)(ws + WSO_GATES);
        const float* ropec = (const float*)(ws + WSO_ROPE); const float* ropes = ropec + SEQ * 32;
        if (pn < 6 || pn == 10) {
            bf16_t* base; int pitch, c0; float sc = 1.f;
            if (pn < 2) { base = qsb; pitch = SBW; c0 = pn * 256; sc = QSCALE; } else if (pn < 4) { base = ksb; pitch = SBW; c0 = (pn - 2) * 256; }
            else if (pn < 6) { base = vsb; pitch = SBW; c0 = (pn - 4) * 256; } else { base = vdl; pitch = DKVW; c0 = 0; }
#pragma unroll
            for (int ai = 0; ai < 2; ++ai)
#pragma unroll
                for (int m = 0; m < 4; ++m) { const int row = u.pm * BM + ai * HALF + wr * 64 + m * 16 + fr; const float r = rs[ai][m] * sc;
#pragma unroll
                    for (int bj = 0; bj < 2; ++bj) *(u32x4*)(base + (size_t)row * pitch + c0 + bj * HALF + wc * 32 + 8 * fq) = pack8(acc[ai][bj][m][0] * r, acc[ai][bj][m][1] * r); }
        } else if (pn < 10) {
            bf16_t* base; int pitch, c0; float sc = 1.f;
            if (pn < 9) { base = qdl; pitch = DQW; c0 = (pn - 6) * 256; sc = QSCALE; } else { base = kdl; pitch = DKVW; c0 = 0; }
#pragma unroll
            for (int ai = 0; ai < 2; ++ai)
#pragma unroll
                for (int m = 0; m < 4; ++m) { const int row = u.pm * BM + ai * HALF + wr * 64 + m * 16 + fr; const float r = rs[ai][m]; const int pos = row & (SEQ - 1);
                    f32x4 o1[2], o2[2];
#pragma unroll
                    for (int n = 0; n < 2; ++n) { const f32x4 c = *(const f32x4*)(ropec + pos * 32 + 8 * fq + 4 * n) * sc, s = *(const f32x4*)(ropes + pos * 32 + 8 * fq + 4 * n) * sc;
                        const f32x4 t1 = acc[ai][0][m][n] * r, t2 = acc[ai][1][m][n] * r; o1[n] = t1 * c - t2 * s; o2[n] = t2 * c + t1 * s; }
                    bf16_t* rp = base + (size_t)row * pitch + c0 + wc * 64 + 8 * fq;
                    *(u32x4*)(rp) = pack8(o1[0], o1[1]); *(u32x4*)(rp + 32) = pack8(o2[0], o2[1]);
                    asm volatile("" ::: "memory"); }
        } else {
            const int c0 = (pn - 11) * 256;
#pragma unroll
            for (int ai = 0; ai < 2; ++ai)
#pragma unroll
                for (int m = 0; m < 4; ++m) { const int row = u.pm * BM + ai * HALF + wr * 64 + m * 16 + fr; const float r = rs[ai][m];
#pragma unroll
                    for (int bj = 0; bj < 2; ++bj) { const int col = c0 + bj * HALF + wc * 32 + 8 * fq; f32x4 o[2];
#pragma unroll
                        for (int n = 0; n < 2; ++n) { const f32x4 v = acc[ai][bj][m][n] * r + *(const f32x4*)(bgate + col + 4 * n);
#pragma unroll
                            for (int e = 0; e < 4; ++e) o[n][e] = __builtin_amdgcn_rcpf(1.0f + __builtin_amdgcn_exp2f(-v[e] * LOG2E)); }
                        *(u32x4*)(gates + (size_t)row * 2048 + col) = pack8(o[0], o[1]); }
                    asm volatile("" ::: "memory"); }
        }
    }
};
template <bool SECOND> struct EpiGate {
    static constexpr bool PERM = true, AFTER_DRAIN = false;
    bf16_t* mbuf; const bf16_t* gates; int goff;
    __device__ __forceinline__ void operator()(const f32x4 (&acc)[2][2][4][2], const Unit& u, int wr, int wc, int fr, int fq) const {
#pragma unroll
        for (int ai = 0; ai < 2; ++ai)
#pragma unroll
            for (int m = 0; m < 4; ++m) { const int row = u.pm * BM + ai * HALF + wr * 64 + m * 16 + fr;
#pragma unroll
                for (int bj = 0; bj < 2; ++bj) { const int col = u.pn * BM + bj * HALF + wc * 32 + 8 * fq;
                    const u32x4 g = *(const u32x4*)(gates + (size_t)row * 2048 + goff + col);
                    f32x4 o0 = acc[ai][bj][m][0] * (f32x4){bf_lo(g.x), bf_hi(g.x), bf_lo(g.y), bf_hi(g.y)}, o1 = acc[ai][bj][m][1] * (f32x4){bf_lo(g.z), bf_hi(g.z), bf_lo(g.w), bf_hi(g.w)};
                    bf16_t* p = mbuf + (size_t)row * DMODEL + col;
                    if (SECOND) { const u32x4 t = *(const u32x4*)p; o0 += (f32x4){bf_lo(t.x), bf_hi(t.x), bf_lo(t.y), bf_hi(t.y)}; o1 += (f32x4){bf_lo(t.z), bf_hi(t.z), bf_lo(t.w), bf_hi(t.w)}; }
                    *(u32x4*)p = pack8(o0, o1); }
                asm volatile("" ::: "memory"); }
    }
};

template <class Epi, class Sched, bool ALIGN_EPI = false, bool SP2 = false>
__device__ __forceinline__ void gemm_phase(PG8_LAS unsigned char* lds, const Gemm g, const Sched& S, const Epi& E) {
    const int tid = threadIdx.x, wid = __builtin_amdgcn_readfirstlane(tid >> 6), lane = tid & 63, wr = wid >> 2, wc = wid & 3, fr = lane & 15, fq = lane >> 4;
    const int K = g.K, nt = K / BK;
    unsigned voffA[2], voffB[2];
#pragma unroll
    for (int i = 0; i < 2; ++i) { int R, C; stage_rc(tid * 16 + i * 8192, R, C); const int Rb = Epi::PERM ? ((R & ~31) + perm32(R & 31)) : R;
        voffA[i] = (unsigned)(R * K + C) * 2u; voffB[i] = (unsigned)(Rb * K + C) * 2u; }
    const size_t kstep = (size_t)(BK * 2);
    const size_t hstep = (size_t)HALF * K * 2;
    const size_t tstep = 2 * hstep;
    const unsigned ldsw = (unsigned)wid * 1024u;
    const int aoff = lds_byte(wr * 64 + fr, fq * 8), boff = lds_byte(wc * 32 + fr, fq * 8);
#define PG8_SA(b, h) (((b) * 2 + (h)) * HTB)
#define PG8_SB(b, h) ((4 + (b) * 2 + (h)) * HTB)
#define PG8_STAGE(bufoff, gbase, voff) do { _Pragma("unroll") for (int _i = 0; _i < 2; ++_i) \
        __builtin_amdgcn_global_load_lds((const unsigned*)((const char*)(gbase) + (voff)[_i]), (PG8_LAS unsigned*)(lds + (bufoff) + ldsw + _i * 8192), 16, 0, 0); } while (0)
#define PG8_LDA(dst, b, h) do { _Pragma("unroll") for (int m = 0; m < 4; ++m) _Pragma("unroll") for (int k = 0; k < 2; ++k) dst[m][k] = *(const PG8_LAS bf16x8*)(lds + PG8_SA(b, h) + aoff + m * 2048 + k * 1024); } while (0)
#define PG8_LDB(dst, b, h) do { _Pragma("unroll") for (int n = 0; n < 2; ++n) _Pragma("unroll") for (int k = 0; k < 2; ++k) dst[n][k] = *(const PG8_LAS bf16x8*)(lds + PG8_SB(b, h) + boff + n * 2048 + k * 1024); } while (0)
#define PG8_MMA(ai, bj, At, Bt) do { __builtin_amdgcn_s_setprio(1); _Pragma("unroll") for (int m = 0; m < 4; ++m) _Pragma("unroll") for (int n = 0; n < 2; ++n) _Pragma("unroll") for (int k = 0; k < 2; ++k) \
        acc[ai][bj][m][n] = __builtin_amdgcn_mfma_f32_16x16x32_bf16(Bt[n][k], At[m][k], acc[ai][bj][m][n], 0, 0, 0); __builtin_amdgcn_s_setprio(0); } while (0)
#define PG8_WAIT_V(n) asm volatile("s_waitcnt vmcnt(" #n ")" ::: "memory")
#define PG8_WAIT_L(n) asm volatile("s_waitcnt lgkmcnt(" #n ")" ::: "memory")
#define PG8_BAR __builtin_amdgcn_s_barrier()
#define PG8_SCHED __builtin_amdgcn_sched_barrier(0)
    Unit cur, nxt; int ui = 0;
    if (!S.next(0, cur)) return;
    f32x4 acc[2][2][4][2];
#pragma unroll
    for (int a = 0; a < 2; ++a)
#pragma unroll
        for (int b = 0; b < 2; ++b)
#pragma unroll
            for (int m = 0; m < 4; ++m)
#pragma unroll
                for (int n = 0; n < 2; ++n) acc[a][b][m][n] = (f32x4){0.f, 0.f, 0.f, 0.f};
    bf16x8 At[4][2], B0[2][2], B1[2][2];
    const char* cA = (const char*)g.A + (size_t)cur.pm * tstep; const char* cB = (const char*)g.Bt + (size_t)cur.pn * tstep;
    S.a_ready(cur);
    if constexpr (SP2) {
        PG8_STAGE(PG8_SB(0, 0), cB, voffB); PG8_STAGE(PG8_SB(0, 1), cB + hstep, voffB); PG8_STAGE(PG8_SA(0, 0), cA, voffA); PG8_STAGE(PG8_SA(0, 1), cA + hstep, voffA);
        if (wr == 1) PG8_BAR;
        PG8_WAIT_V(2); PG8_BAR;
        PG8_STAGE(PG8_SB(1, 0), cB + kstep, voffB); PG8_STAGE(PG8_SA(1, 0), cA + kstep, voffA); PG8_STAGE(PG8_SB(1, 1), cB + hstep + kstep, voffB);
        PG8_WAIT_V(6); PG8_BAR;
    } else {
        PG8_STAGE(PG8_SB(0, 0), cB, voffB); PG8_STAGE(PG8_SA(0, 0), cA, voffA); PG8_STAGE(PG8_SB(0, 1), cB + hstep, voffB); PG8_STAGE(PG8_SA(0, 1), cA + hstep, voffA);
        if (wr == 1) PG8_BAR;
        PG8_WAIT_V(4); PG8_BAR;
        PG8_STAGE(PG8_SB(1, 0), cB + kstep, voffB); PG8_STAGE(PG8_SA(1, 0), cA + kstep, voffA); PG8_STAGE(PG8_SB(1, 1), cB + hstep + kstep, voffB);
        PG8_WAIT_V(6); PG8_BAR;
    }
    for (;;) {
        const bool has_next = S.next(ui + 1, nxt);
        const char* nA = has_next ? (const char*)g.A + (size_t)nxt.pm * tstep : cA; const char* nB = has_next ? (const char*)g.Bt + (size_t)nxt.pn * tstep : cB;
        for (int t = 0; t < nt; t += 2) {
            const bool last = (t == nt - 2);
            const char* a1 = cA + (size_t)(t + 1) * kstep;
            const char* a2 = last ? nA : cA + (size_t)(t + 2) * kstep; const char* b2 = last ? nB : cB + (size_t)(t + 2) * kstep;
            const char* a3 = a2 + kstep; const char* b3 = b2 + kstep;
            if (last && has_next) S.a_ready(nxt);
            if constexpr (SP2) {
            PG8_LDB(B0, 0, 0); PG8_LDB(B1, 0, 1); PG8_SCHED; PG8_LDA(At, 0, 0); PG8_STAGE(PG8_SA(1, 1), a1 + hstep, voffA);
            PG8_WAIT_V(8); PG8_WAIT_L(0); PG8_BAR; PG8_MMA(0, 0, At, B0); PG8_MMA(0, 1, At, B1); PG8_BAR; PG8_SCHED;
            PG8_LDA(At, 0, 1); PG8_STAGE(PG8_SB(0, 0), b2, voffB); PG8_STAGE(PG8_SB(0, 1), b2 + hstep, voffB); PG8_STAGE(PG8_SA(0, 0), a2, voffA);
            PG8_WAIT_V(8); PG8_WAIT_L(0); PG8_BAR; PG8_MMA(1, 0, At, B0); PG8_MMA(1, 1, At, B1); PG8_BAR; PG8_SCHED;
            PG8_LDB(B0, 1, 0); PG8_LDB(B1, 1, 1); PG8_SCHED; PG8_LDA(At, 1, 0); PG8_STAGE(PG8_SA(0, 1), a2 + hstep, voffA);
            PG8_WAIT_V(8); PG8_WAIT_L(0); PG8_BAR; PG8_MMA(0, 0, At, B0); PG8_MMA(0, 1, At, B1); PG8_BAR; PG8_SCHED;
            PG8_LDA(At, 1, 1); PG8_STAGE(PG8_SB(1, 0), b3, voffB); PG8_STAGE(PG8_SB(1, 1), b3 + hstep, voffB); PG8_STAGE(PG8_SA(1, 0), a3, voffA);
            PG8_WAIT_V(8); PG8_WAIT_L(0); PG8_BAR; PG8_MMA(1, 0, At, B0); PG8_MMA(1, 1, At, B1); PG8_BAR; PG8_SCHED;
            } else {
            PG8_LDB(B0, 0, 0); PG8_SCHED; PG8_LDA(At, 0, 0); PG8_STAGE(PG8_SA(1, 1), a1 + hstep, voffA);
            PG8_WAIT_L(8); PG8_BAR; PG8_WAIT_L(0); PG8_MMA(0, 0, At, B0); PG8_BAR; PG8_SCHED;
            PG8_LDB(B1, 0, 1); PG8_STAGE(PG8_SB(0, 0), b2, voffB);
            PG8_BAR; PG8_WAIT_L(0); PG8_MMA(0, 1, At, B1); PG8_BAR;
            PG8_LDA(At, 0, 1); PG8_STAGE(PG8_SA(0, 0), a2, voffA);
            PG8_BAR; PG8_WAIT_L(0); PG8_MMA(1, 0, At, B0); PG8_BAR; PG8_SCHED;
            PG8_STAGE(PG8_SB(0, 1), b2 + hstep, voffB);
            PG8_WAIT_V(6); PG8_BAR; PG8_MMA(1, 1, At, B1); PG8_BAR;
            PG8_LDB(B0, 1, 0); PG8_SCHED; PG8_LDA(At, 1, 0); PG8_STAGE(PG8_SA(0, 1), a2 + hstep, voffA);
            PG8_WAIT_L(8); PG8_BAR; PG8_WAIT_L(0); PG8_MMA(0, 0, At, B0); PG8_BAR; PG8_SCHED;
            PG8_LDB(B1, 1, 1); PG8_STAGE(PG8_SB(1, 0), b3, voffB);
            PG8_BAR; PG8_WAIT_L(0); PG8_MMA(0, 1, At, B1); PG8_BAR;
            PG8_LDA(At, 1, 1); PG8_STAGE(PG8_SA(1, 0), a3, voffA);
            PG8_BAR; PG8_WAIT_L(0); PG8_MMA(1, 0, At, B0); PG8_BAR; PG8_SCHED;
            PG8_STAGE(PG8_SB(1, 1), b3 + hstep, voffB);
            PG8_WAIT_V(6); PG8_BAR; PG8_MMA(1, 1, At, B1); PG8_BAR;
            }
        }
        if constexpr (ALIGN_EPI) { if (wr == 0) PG8_BAR; }
        if constexpr (!Epi::AFTER_DRAIN) { E(acc, cur, wr, wc, fr, fq); S.done(cur); }
        if (!has_next) break;
#pragma unroll
        for (int a = 0; a < 2; ++a)
#pragma unroll
            for (int b = 0; b < 2; ++b)
#pragma unroll
                for (int m = 0; m < 4; ++m)
#pragma unroll
                    for (int n = 0; n < 2; ++n) acc[a][b][m][n] = (f32x4){0.f, 0.f, 0.f, 0.f};
        cur = nxt; cA = nA; cB = nB; ++ui;
        if constexpr (ALIGN_EPI) { if (wr == 1) PG8_BAR; }
    }
    PG8_WAIT_V(0);
    if constexpr (!ALIGN_EPI) { if (wr == 0) PG8_BAR; }
    PG8_BAR;
    if constexpr (Epi::AFTER_DRAIN) { E.fused(acc, cur, wr, wc, fr, fq, lds, wid, lane); S.done(cur); }
#undef PG8_SA
#undef PG8_SB
#undef PG8_STAGE
#undef PG8_LDA
#undef PG8_LDB
#undef PG8_MMA
#undef PG8_WAIT_V
#undef PG8_WAIT_L
#undef PG8_BAR
#undef PG8_SCHED
}
}
#define LAS __attribute__((address_space(3)))
typedef unsigned short bf16;
typedef unsigned v4u __attribute__((ext_vector_type(4)));
typedef float f32x4 __attribute__((ext_vector_type(4)));
typedef short s16x8 __attribute__((ext_vector_type(8)));
typedef float f32x16 __attribute__((ext_vector_type(16)));
#define LDS_WAIT() asm volatile("s_waitcnt lgkmcnt(0)" ::: "memory")
constexpr int NWAVES = 8, NTHREADS = 512;
constexpr int RING_BYTES = 131072, LDS_BYTES = 147456;
constexpr size_t MiB = 1u << 20, HMiB = 1u << 19;
constexpr size_t WS_W13A = 0, WS_W2A = 11 * MiB, WS_WIN = 33 * HMiB, WS_WSB = 26 * MiB, WS_WDIL = 27 * MiB, WS_WO = 55 * HMiB, WS_W13B = 59 * HMiB, WS_W2B = 81 * HMiB;
constexpr size_t WS_ROPE = 46 * MiB, WS_RSS = 48 * MiB, WS_YDL = 49 * MiB, WS_XB = 57 * MiB;
constexpr size_t WS_U = 89 * MiB;
constexpr size_t WS_QSB = 89 * MiB, WS_KSB = 105 * MiB, WS_VSB = 121 * MiB, WS_QDL = 137 * MiB, WS_KDL = 161 * MiB, WS_VDL = 169 * MiB, WS_GATES = 177 * MiB;
constexpr size_t WS_MBUF = WS_KSB;
constexpr size_t WS_LSE = 241 * MiB, WS_CTL = 242 * MiB, WS_END = 243 * MiB;
static_assert(WS_ROPE == WSO_ROPE && WS_RSS == WSO_RSS && WS_QSB == WSO_QSB && WS_KSB == WSO_KSB && WS_VSB == WSO_VSB && WS_QDL == WSO_QDL && WS_KDL == WSO_KDL && WS_VDL == WSO_VDL && WS_GATES == WSO_GATES, "d_ws map");
static_assert(WS_W13A + (size_t)2 * DFF * DMODEL * 2 == WS_W2A && WS_W2A + (size_t)DMODEL * DFF * 2 == WS_WIN && WS_WIN + (size_t)INW * DMODEL * 2 == WS_WSB && WS_WO + (size_t)DMODEL * DMODEL * 2 == WS_W13B
              && WS_W13B + (size_t)2 * DFF * DMODEL * 2 == WS_W2B && WS_W2B + (size_t)DMODEL * DFF * 2 == WS_ROPE && WS_U + (size_t)MTOK * DFF * 2 == WS_GATES && WS_GATES + (size_t)MTOK * 2048 * 2 == WS_LSE, "d_ws map");

__device__ __forceinline__ unsigned f2bf(float f) { unsigned u = __builtin_bit_cast(unsigned, f); return (u + 0x7fffu + ((u >> 16) & 1u)) >> 16; }
__device__ __forceinline__ unsigned pk2(float lo, float hi) { return f2bf(lo) | (f2bf(hi) << 16); }
__device__ __forceinline__ float wave_sum(float v) {
#pragma unroll
    for (int o = 1; o < 64; o <<= 1) v += __shfl_xor(v, o);
    return v;
}
__device__ __forceinline__ void transpose_item(const float* W, int N, const float* g, bf16* WT, int Kd, int k0, int n0, int drow0, LAS float* scr, int lane) {
#pragma unroll 8
    for (int i = 0; i < 32; ++i) { const int kk = 2 * i + (lane >> 5); float v = W[(size_t)(k0 + kk) * N + n0 + (lane & 31)]; if (g) v *= g[k0 + kk]; scr[kk * 33 + (lane & 31)] = v; }
    LDS_WAIT(); asm volatile("" ::: "memory");
    const int c = lane & 7;
#pragma unroll
    for (int j = 0; j < 4; ++j) { const int n = (lane >> 3) + 8 * j; const LAS float* s = scr + (8 * c) * 33 + n;
        v4u o; o.x = pk2(s[0 * 33], s[1 * 33]); o.y = pk2(s[2 * 33], s[3 * 33]); o.z = pk2(s[4 * 33], s[5 * 33]); o.w = pk2(s[6 * 33], s[7 * 33]);
        *(v4u*)(WT + (size_t)(drow0 + n) * Kd + k0 + 8 * c) = o; }
    LDS_WAIT(); asm volatile("" ::: "memory");
}
struct Ptrs {
    const float *x, *g_ffn1, *w1_a, *w3_a, *w2_a, *g_mix, *w_in, *b_gate, *w_sb_out, *w_dil_out, *w_o, *g_ffn2, *w1_b, *w3_b, *w2_b, *g_final;
    float* out; unsigned char* ws;
};
__device__ __forceinline__ void p0_prologue(const Ptrs& P, LAS unsigned char* lds, int gw, int NGW, int wave, int lane) {
    LAS float* scr = (LAS float*)(lds + wave * 16384);
    unsigned char* ws = P.ws;
    constexpr int I_UP = (DMODEL / 64) * (DFF / 32), I_DN = (DFF / 64) * (DMODEL / 32), I_IN = (DMODEL / 64) * (INW / 32), I_SB = (SBW / 64) * (DMODEL / 32), I_DL = (DKVW / 64) * (DMODEL / 32), I_O = (DMODEL / 64) * (DMODEL / 32);
    constexpr int NITEMS = 4 * I_UP + 2 * I_DN + I_IN + I_SB + I_DL + I_O;
    for (int it = gw; it < NITEMS; it += NGW) {
        int r = it;
        if (r < 4 * I_UP) {
            const int which = r / I_UP; r -= which * I_UP; const int nblk = DFF / 32, k0 = 64 * (r / nblk), n0 = 32 * (r % nblk);
            const float* W = which == 0 ? P.w1_a : which == 1 ? P.w3_a : which == 2 ? P.w1_b : P.w3_b;
            bf16* WT = (bf16*)(ws + (which < 2 ? WS_W13A : WS_W13B));
            transpose_item(W, DFF, which < 2 ? P.g_ffn1 : P.g_ffn2, WT, DMODEL, k0, n0, 256 * (n0 / 128) + 128 * (which & 1) + (n0 % 128), scr, lane); continue; }
        r -= 4 * I_UP;
        if (r < 2 * I_DN) { const int which = r / I_DN; r -= which * I_DN; const int nblk = DMODEL / 32, k0 = 64 * (r / nblk), n0 = 32 * (r % nblk);
            transpose_item(which ? P.w2_b : P.w2_a, DMODEL, nullptr, (bf16*)(ws + (which ? WS_W2B : WS_W2A)), DFF, k0, n0, n0, scr, lane); continue; }
        r -= 2 * I_DN;
        if (r < I_IN) { const int nblk = INW / 32, k0 = 64 * (r / nblk), n0 = 32 * (r % nblk); int drow = n0;
            if (n0 >= 1536 && n0 < 2560) { const int a0 = n0 & 255; drow = (n0 & ~255) + 128 * ((a0 >> 5) & 1) + 32 * (a0 >> 6); }
            transpose_item(P.w_in, INW, P.g_mix, (bf16*)(ws + WS_WIN), DMODEL, k0, n0, drow, scr, lane); continue; }
        r -= I_IN;
        if (r < I_SB) { const int nblk = DMODEL / 32, k0 = 64 * (r / nblk), n0 = 32 * (r % nblk); transpose_item(P.w_sb_out, DMODEL, nullptr, (bf16*)(ws + WS_WSB), SBW, k0, n0, n0, scr, lane); continue; }
        r -= I_SB;
        if (r < I_DL) { const int nblk = DMODEL / 32, k0 = 64 * (r / nblk), n0 = 32 * (r % nblk); transpose_item(P.w_dil_out, DMODEL, nullptr, (bf16*)(ws + WS_WDIL), DKVW, k0, n0, n0, scr, lane); continue; }
        r -= I_DL;
        { const int nblk = DMODEL / 32, k0 = 64 * (r / nblk), n0 = 32 * (r % nblk); transpose_item(P.w_o, DMODEL, nullptr, (bf16*)(ws + WS_WO), DMODEL, k0, n0, n0, scr, lane); }
    }
    bf16* xb = (bf16*)(ws + WS_XB); float* rowss = (float*)(ws + WS_RSS);
    for (int m = gw; m < MTOK; m += NGW) {
        const f32x4* xr = (const f32x4*)(P.x + (size_t)m * DMODEL) + lane; f32x4 v[4]; float s = 0.f;
#pragma unroll
        for (int j = 0; j < 4; ++j) { v[j] = xr[64 * j]; s += (v[j].x * v[j].x + v[j].y * v[j].y) + (v[j].z * v[j].z + v[j].w * v[j].w); }
        s = wave_sum(s);
        unsigned long long* o8 = (unsigned long long*)(xb + (size_t)m * DMODEL) + lane;
#pragma unroll
        for (int j = 0; j < 4; ++j) o8[64 * j] = (unsigned long long)pk2(v[j].x, v[j].y) | ((unsigned long long)pk2(v[j].z, v[j].w) << 32);
        if (lane < 16) rowss[(size_t)m * 16 + lane] = lane == 0 ? s : 0.f;
    }
    float* ropec = (float*)(ws + WS_ROPE); float* ropes = ropec + SEQ * 32;
    for (int e = gw * 64 + lane; e < SEQ * 32; e += NGW * 64) { const int pos = e >> 5, i = e & 31;
        const float invf = powf(10000.0f, -(float)i / 32.0f); const float ang = (float)pos * invf;
        double rev = (double)ang * 0.15915494309189535; rev -= __builtin_rint(rev); const float fr = (float)rev;
        ropec[e] = __builtin_amdgcn_cosf(fr); ropes[e] = __builtin_amdgcn_sinf(fr); }
}
__device__ __forceinline__ int crow(int r, int hi) { return (r & 3) + 8 * (r >> 2) + 4 * hi; }
__device__ __forceinline__ unsigned cvtpk(float lo, float hi) { unsigned r; asm volatile("v_cvt_pk_bf16_f32 %0, %1, %2" : "=v"(r) : "v"(lo), "v"(hi)); return r; }
__device__ __forceinline__ s16x8 pack_p(const f32x16& p, int c) { v4u w; w.x = cvtpk(p[8 * c + 0], p[8 * c + 1]); w.y = cvtpk(p[8 * c + 2], p[8 * c + 3]); w.z = cvtpk(p[8 * c + 4], p[8 * c + 5]); w.w = cvtpk(p[8 * c + 6], p[8 * c + 7]); return __builtin_bit_cast(s16x8, w); }
constexpr int VT_PITCH = 72, VT_BYTES = 32 * VT_PITCH * 2;
struct VRegs { s16x8 t[4]; };
__device__ __forceinline__ void vload(VRegs& v, const bf16* vsrc  , unsigned rstride, int lane) {
    const bf16* p = vsrc + (size_t)((unsigned)(lane >> 1) * rstride + (unsigned)(lane & 1) * 32u);
#pragma unroll
    for (int i = 0; i < 4; ++i) v.t[i] = *(const s16x8*)(p + 8 * i);
}
__device__ __forceinline__ void vfrags(s16x8 (&vf)[2][2], const VRegs& v, LAS bf16* vt, int lane) {
    const int r32 = lane & 31, hi = lane >> 5;
    asm volatile("s_waitcnt lgkmcnt(0)" ::: "memory");
    LAS bf16* wp = vt + (lane >> 1) * VT_PITCH + (lane & 1) * 32;
#pragma unroll
    for (int i = 0; i < 4; ++i) *(LAS s16x8*)(wp + 8 * i) = v.t[i];
    asm volatile("s_waitcnt lgkmcnt(0)" ::: "memory");
    const LAS bf16* rp = vt + 4 * hi * VT_PITCH + r32;
#pragma unroll
    for (int c = 0; c < 2; ++c)
#pragma unroll
        for (int e = 0; e < 8; ++e) { const int key = ((8 * c + e) & 3) + 8 * ((8 * c + e) >> 2); vf[0][c][e] = (short)rp[key * VT_PITCH]; vf[1][c][e] = (short)rp[key * VT_PITCH + 32]; }
}
__device__ __forceinline__ void store_o(bf16* ob  , unsigned rstride, const f32x16& o0, const f32x16& o1, LAS bf16* vt, int lane) {
    const int r32 = lane & 31, hi = lane >> 5;
    asm volatile("s_waitcnt lgkmcnt(0)" ::: "memory");
    LAS bf16* wp = vt + 4 * hi * VT_PITCH + r32;
#pragma unroll
    for (int r = 0; r < 16; ++r) { const int row = (r & 3) + 8 * (r >> 2); wp[row * VT_PITCH] = (bf16)f2bf(o0[r]); wp[row * VT_PITCH + 32] = (bf16)f2bf(o1[r]); }
    asm volatile("s_waitcnt lgkmcnt(0)" ::: "memory");
    const LAS bf16* rp = vt + (lane >> 1) * VT_PITCH + (lane & 1) * 32;
    bf16* gp = ob + (size_t)((unsigned)(lane >> 1) * rstride + (unsigned)(lane & 1) * 32u);
#pragma unroll
    for (int i = 0; i < 4; ++i) *(s16x8*)(gp + 8 * i) = *(const LAS s16x8*)(rp + 8 * i);
}
__device__ __forceinline__ void kload(s16x8 (&kf)[4], const bf16* ksrc  , unsigned rstride, int lane) {
    const bf16* p = ksrc + (size_t)((unsigned)(lane & 31) * rstride + (unsigned)(lane >> 5) * 8u);
#pragma unroll
    for (int d0 = 0; d0 < 4; ++d0) kf[d0] = *(const s16x8*)(p + 16 * d0);
}
__device__ __forceinline__ void sb_item(int item, bf16* QO, const bf16* K, const bf16* V, LAS bf16* vt, int lane) {
    const int r32 = lane & 31, hi = lane >> 5;
    const int qb = 255 - (item & 255), h = (item >> 8) & 7, b = item >> 11;
    const int t0 = qb * 32; const size_t rowb = (size_t)b * SEQ;
    s16x8 qr[4]; kload(qr, QO + (rowb + t0) * SBW + h * 64, SBW, lane);
    const bf16* Kh = K + rowb * SBW + h * 64; const bf16* Vh = V + rowb * SBW + h * 64;
    f32x16 o0 = {}, o1 = {}; float carry = 0.f;
    s16x8 kn[4]; VRegs vn; kload(kn, Kh + (size_t)t0 * SBW, SBW, lane); vload(vn, Vh + (size_t)t0 * SBW, SBW, lane);
    for (int kb = t0; kb >= 0; kb -= 32) {
        s16x8 kf[4]; VRegs vc;
#pragma unroll
        for (int d0 = 0; d0 < 4; ++d0) { kf[d0] = kn[d0]; vc.t[d0] = vn.t[d0]; }
        if (kb >= 32) { kload(kn, Kh + (size_t)(kb - 32) * SBW, SBW, lane); vload(vn, Vh + (size_t)(kb - 32) * SBW, SBW, lane); }
        f32x16 s = {};
#pragma unroll
        for (int d0 = 0; d0 < 4; ++d0) s = __builtin_amdgcn_mfma_f32_32x32x16_bf16(kf[d0], qr[d0], s, 0, 0, 0);
        const bool diag = (kb == t0);
        int lim = diag ? r32 - 4 * hi : 64; asm volatile("" : "+v"(lim));
        float ls[16], ln[16];
#pragma unroll
        for (int r = 0; r < 16; ++r) { const float z = s[r]; const float lp = __builtin_amdgcn_logf(1.0f + __builtin_amdgcn_exp2f(-__builtin_fabsf(z)));
            ls[r] = __builtin_fminf(z, 0.f) - lp; ln[r] = __builtin_fminf(-z, 0.f) - lp;
            if (!(((r & 3) + 8 * (r >> 2)) < lim)) { ln[r] = 0.f; ls[r] = -INFINITY; } }
        float tot[4], pg[4];
#pragma unroll
        for (int g = 0; g < 4; ++g) { const float gs = (ln[4 * g] + ln[4 * g + 1]) + (ln[4 * g + 2] + ln[4 * g + 3]); pg[g] = __shfl_xor(gs, 32); tot[g] = gs + pg[g]; }
        float T[4]; T[3] = 0.f; T[2] = tot[3]; T[1] = T[2] + tot[2]; T[0] = T[1] + tot[1]; const float total = T[0] + tot[0];
        f32x16 a;
#pragma unroll
        for (int g = 0; g < 4; ++g) { const float w3 = carry + T[g] + (hi == 0 ? pg[g] : 0.f), w2 = w3 + ln[4 * g + 3], w1 = w2 + ln[4 * g + 2], w0 = w1 + ln[4 * g + 1];
            a[4 * g + 0] = __builtin_amdgcn_exp2f(ls[4 * g + 0] + w0); a[4 * g + 1] = __builtin_amdgcn_exp2f(ls[4 * g + 1] + w1);
            a[4 * g + 2] = __builtin_amdgcn_exp2f(ls[4 * g + 2] + w2); a[4 * g + 3] = __builtin_amdgcn_exp2f(ls[4 * g + 3] + w3); }
        carry += total;
        const s16x8 pa0 = pack_p(a, 0), pa1 = pack_p(a, 1);
        s16x8 vf[2][2]; vfrags(vf, vc, vt, lane);
        o0 = __builtin_amdgcn_mfma_f32_32x32x16_bf16(pa0, vf[0][0], o0, 0, 0, 0); o0 = __builtin_amdgcn_mfma_f32_32x32x16_bf16(pa1, vf[0][1], o0, 0, 0, 0);
        o1 = __builtin_amdgcn_mfma_f32_32x32x16_bf16(pa0, vf[1][0], o1, 0, 0, 0); o1 = __builtin_amdgcn_mfma_f32_32x32x16_bf16(pa1, vf[1][1], o1, 0, 0, 0);
        if (__all(carry < -150.0f)) break;
    }
    store_o(QO + (rowb + t0) * SBW + h * 64, SBW, o0, o1, vt, lane);
}
__device__ __forceinline__ void dl_item(int item, bf16* QO, const bf16* K, const bf16* V, float* LSE, LAS bf16* vt, int lane) {
    const int r32 = lane & 31, hi = lane >> 5;
    const int g = item >> 11, rem = item & 2047, b = rem >> 10, j = (rem >> 8) & 3, blk = rem & 255;
    const int dsh = 2 * g, dil = 1 << dsh, nsb = 256 >> dsh, rr = blk / nsb, i0 = (blk % nsb) * 32;
    const size_t rowb = (size_t)b * SEQ + rr;
    const unsigned qstride = (unsigned)dil * DQW, kstride = (unsigned)dil * DKVW;
    bf16* Qb = QO + (rowb + (size_t)dil * i0) * DQW + (g * 4 + j) * 64;
    s16x8 qr[4]; kload(qr, Qb, qstride, lane);
    const bf16* Kh = K + rowb * DKVW + j * 64; const bf16* Vh = V + rowb * DKVW + j * 64;
    f32x16 sc[5]; float mx = -INFINITY; const float flim = (float)(r32 - 4 * hi);
#pragma unroll
    for (int n = 0; n < 5; ++n) { const int kbi = i0 - 128 + 32 * n;
        if (kbi >= 0) {
            s16x8 kf[4]; kload(kf, Kh + (size_t)kbi * kstride, kstride, lane);
            f32x16 s = {};
#pragma unroll
            for (int d0 = 0; d0 < 4; ++d0) s = __builtin_amdgcn_mfma_f32_32x32x16_bf16(kf[d0], qr[d0], s, 0, 0, 0);
#pragma unroll
            for (int r = 0; r < 16; ++r) {
                if (n == 0) s[r] = __builtin_fminf(s[r], ((float)((r & 3) + 8 * (r >> 2)) - flim + 0.5f) * 6e38f);
                if (n == 4) s[r] = __builtin_fminf(s[r], (flim - (float)((r & 3) + 8 * (r >> 2)) + 0.5f) * 6e38f);
                mx = __builtin_fmaxf(mx, s[r]); }
            sc[n] = s;
        } else {
#pragma unroll
            for (int r = 0; r < 16; ++r) sc[n][r] = -INFINITY;
        }
    }
    mx = __builtin_fmaxf(mx, __shfl_xor(mx, 32));
    float l = 0.f;
#pragma unroll
    for (int n = 0; n < 5; ++n)
#pragma unroll
        for (int r = 0; r < 16; ++r) { const float p = __builtin_amdgcn_exp2f(sc[n][r] - mx); sc[n][r] = p; l += p; }
    l += __shfl_xor(l, 32);
    const float inv = 1.0f / l;
    f32x16 o0 = {}, o1 = {};
#pragma unroll
    for (int n = 0; n < 5; ++n) { const int kbi = i0 - 128 + 32 * n;
        if (kbi >= 0) {
            VRegs vc; vload(vc, Vh + (size_t)kbi * kstride, kstride, lane);
            f32x16 p = sc[n] * inv;
            const s16x8 pa0 = pack_p(p, 0), pa1 = pack_p(p, 1);
            s16x8 vf[2][2]; vfrags(vf, vc, vt, lane);
            o0 = __builtin_amdgcn_mfma_f32_32x32x16_bf16(pa0, vf[0][0], o0, 0, 0, 0); o0 = __builtin_amdgcn_mfma_f32_32x32x16_bf16(pa1, vf[0][1], o0, 0, 0, 0);
            o1 = __builtin_amdgcn_mfma_f32_32x32x16_bf16(pa0, vf[1][0], o1, 0, 0, 0); o1 = __builtin_amdgcn_mfma_f32_32x32x16_bf16(pa1, vf[1][1], o1, 0, 0, 0);
        }
    }
    store_o(Qb, qstride, o0, o1, vt, lane);
    if (hi == 0) LSE[((size_t)g * MTOK + rowb + (size_t)dil * (i0 + r32)) * 4 + j] = mx + __builtin_amdgcn_logf(l);
}
__device__ __forceinline__ void combine_rows(int pm, const bf16* O, const float* LSE, bf16* YDL, int tid) {
#pragma unroll 4
    for (int k = 0; k < 16; ++k) { const int c = tid + NTHREADS * k, row = pm * 256 + (c >> 5), cc = c & 31, j = cc >> 3;
        const float l0 = LSE[((size_t)0 * MTOK + row) * 4 + j], l1 = LSE[((size_t)1 * MTOK + row) * 4 + j], l2 = LSE[((size_t)2 * MTOK + row) * 4 + j];
        const float M = __builtin_fmaxf(l0, __builtin_fmaxf(l1, l2)); float w0 = __builtin_amdgcn_exp2f(l0 - M), w1 = __builtin_amdgcn_exp2f(l1 - M), w2 = __builtin_amdgcn_exp2f(l2 - M);
        const float inv = 1.0f / (w0 + w1 + w2); w0 *= inv; w1 *= inv; w2 *= inv;
        const bf16* op = O + (size_t)row * DQW + cc * 8;
        const v4u a = *(const v4u*)op, bq = *(const v4u*)(op + 256), cq = *(const v4u*)(op + 512);
        v4u o;
#define CMB(x) pk2(w0 * pg8::bf_lo(a.x) + w1 * pg8::bf_lo(bq.x) + w2 * pg8::bf_lo(cq.x), w0 * pg8::bf_hi(a.x) + w1 * pg8::bf_hi(bq.x) + w2 * pg8::bf_hi(cq.x))
        o.x = CMB(x); o.y = CMB(y); o.z = CMB(z); o.w = CMB(w);
#undef CMB
        *(v4u*)(YDL + (size_t)row * DKVW + cc * 8) = o; }
}

__device__ __forceinline__ void grid_bar(unsigned* ctr, unsigned target) {
    asm volatile("s_waitcnt vmcnt(0)" ::: "memory");
    __syncthreads();
    if (threadIdx.x == 0) {
        __builtin_amdgcn_fence(__ATOMIC_RELEASE, "agent");
        asm volatile("s_waitcnt vmcnt(0)" ::: "memory");
        __hip_atomic_fetch_add(ctr, 1u, __ATOMIC_RELAXED, __HIP_MEMORY_SCOPE_AGENT);
        unsigned spins = 0;
        while (__hip_atomic_load(ctr, __ATOMIC_RELAXED, __HIP_MEMORY_SCOPE_AGENT) < target) { __builtin_amdgcn_s_sleep(2); if (++spins > (1u << 24)) break; }
        __builtin_amdgcn_fence(__ATOMIC_ACQUIRE, "agent");
        asm volatile("s_waitcnt vmcnt(0)" ::: "memory");
    }
    __syncthreads();
}
struct Args { const float* in[16]; float* out; unsigned char* ws; int ph_lo, ph_hi, coop, pad; };
constexpr int NPHASES = 10;
__global__ void __launch_bounds__(NTHREADS, 2) mk_fwd(Args args) {
    extern __shared__ __attribute__((aligned(16))) unsigned char lds_raw[];
    LAS unsigned char* lds = (LAS unsigned char*)lds_raw;
    cg::grid_group grid = cg::this_grid();
    const int tid = threadIdx.x, lane = tid & 63, wave = __builtin_amdgcn_readfirstlane(tid >> 6);
    const int G = gridDim.x, gw = blockIdx.x * NWAVES + wave, NGW = G * NWAVES;
    unsigned char* ws = args.ws;
#define xb ((bf16*)(ws + WS_XB))
#define rowss ((float*)(ws + WS_RSS))
#define U ((bf16*)(ws + WS_U))
#define qsb ((bf16*)(ws + WS_QSB))
#define ksb ((bf16*)(ws + WS_KSB))
#define vsb ((bf16*)(ws + WS_VSB))
#define qdl ((bf16*)(ws + WS_QDL))
#define kdl ((bf16*)(ws + WS_KDL))
#define vdl ((bf16*)(ws + WS_VDL))
#define gates ((bf16*)(ws + WS_GATES))
#define mbuf ((bf16*)(ws + WS_MBUF))
#define ydl ((bf16*)(ws + WS_YDL))
#define lse ((float*)(ws + WS_LSE))
    const int lo = args.ph_lo, hi = args.ph_hi;
#ifndef PHMASK
#define PHMASK 0x3ff
#endif
#define IN(k) (((PHMASK >> (k)) & 1) && lo <= (k) && (k) < hi)
#define SEAM(k) do { if (IN(k) && IN((k) + 1)) { if (args.coop) { if ((k) == 0) grid.sync(); else grid_bar((unsigned*)(ws + WS_CTL), (unsigned)(k) * (unsigned)G); } } } while (0)

    if (IN(0)) { Ptrs P; P.x = args.in[0]; P.g_ffn1 = args.in[1]; P.w1_a = args.in[2]; P.w3_a = args.in[3]; P.w2_a = args.in[4]; P.g_mix = args.in[5]; P.w_in = args.in[6]; P.b_gate = args.in[7];
        P.w_sb_out = args.in[8]; P.w_dil_out = args.in[9]; P.w_o = args.in[10]; P.g_ffn2 = args.in[11]; P.w1_b = args.in[12]; P.w3_b = args.in[13]; P.w2_b = args.in[14]; P.g_final = args.in[15]; P.out = args.out; P.ws = ws;
        if (blockIdx.x == 0 && tid == 0) *(unsigned*)(ws + WS_CTL) = 0u;
        p0_prologue(P, lds, gw, NGW, wave, lane); __syncthreads(); }
    SEAM(0);
    if (IN(1)) { pg8::Gemm g{xb, (const bf16*)(ws + WS_W13A), MTOK, 2 * DFF, DMODEL}; pg8::StaticOrder S; S.init(MTOK, 2 * DFF, G, (int)blockIdx.x);
        pg8::EpiSwiglu E{U, rowss}; pg8::gemm_phase<pg8::EpiSwiglu, pg8::StaticOrder, true, true>(lds, g, S, E); }
    SEAM(1);
    if (IN(2)) { pg8::Gemm g{U, (const bf16*)(ws + WS_W2A), MTOK, DMODEL, DFF}; pg8::StaticOrder S; S.init(MTOK, DMODEL, G, (int)blockIdx.x);
        pg8::EpiResid E{args.in[0], args.out, xb, rowss, 0.5f}; pg8::gemm_phase<pg8::EpiResid, pg8::StaticOrder, true, true>(lds, g, S, E); }
    SEAM(2);
    if (IN(3)) { pg8::Gemm g{xb, (const bf16*)(ws + WS_WIN), MTOK, INW, DMODEL}; pg8::StaticOrder S; S.init(MTOK, INW, G, (int)blockIdx.x);
        pg8::EpiInProj E{ws, args.in[7]}; pg8::gemm_phase<pg8::EpiInProj, pg8::StaticOrder, true, true>(lds, g, S, E); }
    SEAM(3);
    if (IN(4)) {
        constexpr int N_DL = 3 * 2048, N_SB = 2 * 8 * 256; LAS bf16* vt = (LAS bf16*)(lds + wave * 8192);
        for (int it = gw; it < N_DL + N_SB; it += NGW) {
#ifndef NO_DL
            if (it < N_DL) dl_item(it, qdl, kdl, vdl, lse, vt, lane);
#endif
#ifndef NO_SB
            if (it >= N_DL) sb_item(it - N_DL, qsb, ksb, vsb, vt, lane);
#endif
 }
    }
    SEAM(4);
    if (IN(5)) {
        pg8::StaticOrder S; S.init(MTOK, DMODEL, G, (int)blockIdx.x); pg8::Unit u;
        for (int i = 0; S.next(i, u); ++i) combine_rows(u.pm, qdl, lse, ydl, tid);
        asm volatile("s_waitcnt vmcnt(0)" ::: "memory"); __syncthreads();
        { pg8::Gemm g{qsb, (const bf16*)(ws + WS_WSB), MTOK, DMODEL, SBW}; pg8::EpiGate<false> E{mbuf, gates, 0}; pg8::gemm_phase<pg8::EpiGate<false>, pg8::StaticOrder, true, true>(lds, g, S, E); }
        asm volatile("s_waitcnt vmcnt(0)" ::: "memory"); __syncthreads();
        { pg8::Gemm g{ydl, (const bf16*)(ws + WS_WDIL), MTOK, DMODEL, DKVW}; pg8::EpiGate<true> E{mbuf, gates, DMODEL}; pg8::gemm_phase<pg8::EpiGate<true>, pg8::StaticOrder, true, true>(lds, g, S, E); }
    }
    SEAM(5);
    if (IN(6)) { pg8::Gemm g{mbuf, (const bf16*)(ws + WS_WO), MTOK, DMODEL, DMODEL}; pg8::StaticOrder S; S.init(MTOK, DMODEL, G, (int)blockIdx.x);
        pg8::EpiResid E{args.out, args.out, xb, rowss, 1.0f}; pg8::gemm_phase<pg8::EpiResid, pg8::StaticOrder, true, true>(lds, g, S, E); }
    SEAM(6);
    if (IN(7)) { pg8::Gemm g{xb, (const bf16*)(ws + WS_W13B), MTOK, 2 * DFF, DMODEL}; pg8::StaticOrder S; S.init(MTOK, 2 * DFF, G, (int)blockIdx.x);
        pg8::EpiSwiglu E{U, rowss}; pg8::gemm_phase<pg8::EpiSwiglu, pg8::StaticOrder, true, true>(lds, g, S, E); }
    SEAM(7);
    if (IN(8)) { pg8::Gemm g{U, (const bf16*)(ws + WS_W2B), MTOK, DMODEL, DFF}; pg8::StaticOrder S; S.init(MTOK, DMODEL, G, (int)blockIdx.x);
        pg8::EpiResid E{args.out, args.out, nullptr, nullptr, 0.5f}; pg8::gemm_phase<pg8::EpiResid, pg8::StaticOrder, true, true>(lds, g, S, E); }
    SEAM(8);
    if (IN(9)) {
        for (int m = gw; m < MTOK; m += NGW) { f32x4* xr = (f32x4*)(args.out + (size_t)m * DMODEL) + lane; const f32x4* gr = (const f32x4*)args.in[15] + lane; f32x4 v[4]; float s = 0.f;
#pragma unroll
            for (int j = 0; j < 4; ++j) { v[j] = xr[64 * j]; s += (v[j].x * v[j].x + v[j].y * v[j].y) + (v[j].z * v[j].z + v[j].w * v[j].w); }
            const float rstd = 1.0f / sqrtf(wave_sum(s) * (1.0f / DMODEL) + RMS_EPS);
#pragma unroll
            for (int j = 0; j < 4; ++j) xr[64 * j] = v[j] * rstd * gr[64 * j]; }
    }
#undef IN
#undef SEAM
#undef xb
#undef rowss
#undef U
#undef qsb
#undef ksb
#undef vsb
#undef qdl
#undef kdl
#undef vdl
#undef gates
#undef mbuf
#undef ydl
#undef lse
}

#ifndef MK_SINGLE
#define MK_SINGLE 0
#endif
extern "C" void kernel_launch(void* const* d_in, const int* in_sizes, int n_in, void* d_out, int out_size, void* d_ws, size_t ws_size, hipStream_t stream) {
    static int grid = 0;
    if (grid == 0) {
        if (n_in != 16 || in_sizes[0] != MTOK * DMODEL || out_size != MTOK * DMODEL || ws_size < WS_END) { fprintf(stderr, "kernel_launch: unexpected shapes (n_in %d, in0 %d, out %d, ws %zu)\n", n_in, n_in > 0 ? in_sizes[0] : -1, out_size, ws_size); grid = -1; return; }
        int dev = 0, cus = 0, per_cu = 0;
        hipGetDevice(&dev); hipDeviceGetAttribute(&cus, hipDeviceAttributeMultiprocessorCount, dev);
        if (hipFuncSetAttribute((const void*)mk_fwd, hipFuncAttributeMaxDynamicSharedMemorySize, LDS_BYTES) != hipSuccess) { fprintf(stderr, "kernel_launch: hipFuncSetAttribute failed\n"); grid = -1; return; }
        if (hipOccupancyMaxActiveBlocksPerMultiprocessor(&per_cu, (const void*)mk_fwd, NTHREADS, LDS_BYTES) != hipSuccess || per_cu < 1) { fprintf(stderr, "kernel_launch: occupancy query says %d\n", per_cu); per_cu = 1; }
        (void)hipGetLastError();
        grid = cus * 1;
    }
    if (grid < 0) return;
    Args a{};
    for (int i = 0; i < 16; ++i) a.in[i] = (const float*)d_in[i];
    a.out = (float*)d_out; a.ws = (unsigned char*)d_ws;
#if MK_SINGLE
    a.ph_lo = 0; a.ph_hi = NPHASES; a.coop = 1;
    void* kargs[] = {&a};
    hipError_t e = hipLaunchCooperativeKernel((const void*)mk_fwd, dim3(grid), dim3(NTHREADS), kargs, LDS_BYTES, stream);
    if (e != hipSuccess) fprintf(stderr, "kernel_launch: cooperative launch failed: %s (grid %d)\n", hipGetErrorString(e), grid);
#else
    for (int p = 0; p < NPHASES; ++p) { a.ph_lo = p; a.ph_hi = p + 1; a.coop = 0; hipLaunchKernelGGL(mk_fwd, dim3(grid), dim3(NTHREADS), LDS_BYTES, stream, a); }
#endif
}
```

```cpp
#include <hip/hip_runtime.h>
#include <hip/hip_cooperative_groups.h>
#include <cstdio>
#include <cstdint>
namespace cg = cooperative_groups;

constexpr int MTOK = 16384, SEQ = 8192, DMODEL = 1024, DFF = 2816, SBW = 512, DQW = 768, DKVW = 256, INW = 4864;
constexpr float RMS_EPS = 1e-6f;
constexpr float LOG2E = 1.4426950408889634f;
constexpr float QSCALE = 0.125f * 1.4426950408889634f;

constexpr size_t WSO_ROPE = 46u << 20, WSO_RSS = 48u << 20, WSO_QSB = 89u << 20, WSO_KSB = 105u << 20, WSO_VSB = 121u << 20, WSO_QDL = 137u << 20, WSO_KDL = 161u << 20, WSO_VDL = 169u << 20, WSO_GATES = 177u << 20;
namespace pg8 {
#define PG8_LAS __attribute__((address_space(3)))
typedef unsigned short bf16_t;
typedef short bf16x8 __attribute__((ext_vector_type(8)));
typedef float f32x4 __attribute__((ext_vector_type(4)));
typedef unsigned u32x4 __attribute__((ext_vector_type(4)));
constexpr int BM = 256, BK = 64, HALF = 128, HTB = HALF * BK * 2  , STAGE_BYTES = 8 * HTB, NXCD = 8, WGM = 8;

__host__ __device__ __forceinline__ int lds_byte(int r, int c) { const int st = (r >> 4) * 2 + (c >> 5), rr = r & 15, cc = c & 31, ob = rr * 64 + cc * 2; return st * 1024 + (ob ^ (((ob >> 9) & 1) << 5)); }
__host__ __device__ __forceinline__ void stage_rc(int b, int& R, int& C) { const int st = b / 1024, sb = b % 1024, swz = sb ^ (((sb >> 9) & 1) << 5); R = (st >> 1) * 16 + swz / 64; C = (st & 1) * 32 + (swz % 64) / 2; }
__host__ __device__ __forceinline__ int perm32(int rho) { const int n = rho >> 4, i = rho & 15; return 8 * (i >> 2) + 4 * n + (i & 3); }

struct Unit { int pm, pn; };
struct Gemm { const bf16_t* A; const bf16_t* Bt; int M, N, K; };

struct StaticOrder {
    int nM, nN, nwg, G, c;
    __host__ __device__ void init(int M, int N, int G_, int c_) { nM = M / BM; nN = N / BM; nwg = nM * nN; G = G_; c = c_; }
    __host__ __device__ bool next(int i, Unit& u) const {
        const long L = (long)i * G + c; if (L >= nwg) return false;
        int wgid = (int)L; { const int q = nwg / NXCD, r = nwg % NXCD, xcd = wgid % NXCD, off = wgid / NXCD; wgid = (xcd < r ? xcd * (q + 1) : r * (q + 1) + (xcd - r) * q) + off; }
        const int nig = WGM * nN, gid = wgid / nig, fm = gid * WGM, gsz = (nM - fm) < WGM ? (nM - fm) : WGM;
        u.pm = fm + ((wgid % nig) % gsz); u.pn = (wgid % nig) / gsz; return true;
    }
    __device__ __forceinline__ void a_ready(const Unit&) const {}
    __device__ __forceinline__ void done(const Unit&) const {}
};

__device__ __forceinline__ unsigned cvt_pk_bf16(float lo, float hi) { unsigned r; asm volatile("v_cvt_pk_bf16_f32 %0, %1, %2" : "=v"(r) : "v"(lo), "v"(hi)); return r; }
typedef float f32x2 __attribute__((ext_vector_type(2)));
__device__ __forceinline__ u32x4 pack8(const f32x4 a, const f32x4 b) { u32x4 w; w.x = cvt_pk_bf16(a[0], a[1]); w.y = cvt_pk_bf16(a[2], a[3]); w.z = cvt_pk_bf16(b[0], b[1]); w.w = cvt_pk_bf16(b[2], b[3]); return w; }
__device__ __forceinline__ float bf_lo(unsigned w) { return __builtin_bit_cast(float, w << 16); }
__device__ __forceinline__ float bf_hi(unsigned w) { return __builtin_bit_cast(float, w & 0xffff0000u); }
__device__ __forceinline__ void load_rstd(float (&rs)[2][4], const float* rowss, int pm, int wr, int fr, int fq) {
#pragma unroll
    for (int ai = 0; ai < 2; ++ai)
#pragma unroll
        for (int m = 0; m < 4; ++m) { const int row = pm * BM + ai * HALF + wr * 64 + m * 16 + fr;
            const f32x4 p = *(const f32x4*)(rowss + (size_t)row * 16 + fq * 4); float s = (p[0] + p[1]) + (p[2] + p[3]);
            s += __shfl_xor(s, 16); s += __shfl_xor(s, 32); rs[ai][m] = 1.0f / sqrtf(s * (1.0f / DMODEL) + RMS_EPS); }
}
struct EpiSwiglu {
    static constexpr bool PERM = true, AFTER_DRAIN = false;
    bf16_t* U; const float* rowss;
    __device__ __forceinline__ void operator()(const f32x4 (&acc)[2][2][4][2], const Unit& u, int wr, int wc, int fr, int fq) const {
        float rs[2][4]; load_rstd(rs, rowss, u.pm, wr, fr, fq);
        const int col0 = u.pn * 128 + wc * 32 + 8 * fq;
#pragma unroll
        for (int ai = 0; ai < 2; ++ai)
#pragma unroll
            for (int m = 0; m < 4; ++m) { const int row = u.pm * BM + ai * HALF + wr * 64 + m * 16 + fr; const float r = rs[ai][m]; f32x4 o[2];
#pragma unroll
                for (int n = 0; n < 2; ++n) { const f32x4 a = acc[ai][0][m][n] * r, b = acc[ai][1][m][n] * r;
#pragma unroll
                    for (int e = 0; e < 4; ++e) { const float sg = __builtin_amdgcn_rcpf(1.0f + __builtin_amdgcn_exp2f(-a[e] * LOG2E)); o[n][e] = a[e] * sg * b[e]; } }
                *(u32x4*)(U + (size_t)row * DFF + col0) = pack8(o[0], o[1]); }
    }
};
struct EpiResid {
    static constexpr bool PERM = true, AFTER_DRAIN = false;
    const float* res; float* out; bf16_t* xb; float* rowss; float scale;
    __device__ __forceinline__ void operator()(const f32x4 (&acc)[2][2][4][2], const Unit& u, int wr, int wc, int fr, int fq) const {
#pragma unroll
        for (int ai = 0; ai < 2; ++ai)
#pragma unroll
            for (int m = 0; m < 4; ++m) { const int row = u.pm * BM + ai * HALF + wr * 64 + m * 16 + fr; float ss = 0.f;
#pragma unroll
                for (int bj = 0; bj < 2; ++bj) { const size_t off = (size_t)row * DMODEL + u.pn * BM + bj * HALF + wc * 32 + 8 * fq;
                    const f32x4 r0 = *(const f32x4*)(res + off), r1 = *(const f32x4*)(res + off + 4);
                    const f32x4 o0 = r0 + acc[ai][bj][m][0] * scale, o1 = r1 + acc[ai][bj][m][1] * scale;
                    *(f32x4*)(out + off) = o0; *(f32x4*)(out + off + 4) = o1;
                    if (xb) *(u32x4*)(xb + off) = pack8(o0, o1);
                    ss += (o0[0] * o0[0] + o0[1] * o0[1]) + (o0[2] * o0[2] + o0[3] * o0[3]) + (o1[0] * o1[0] + o1[1] * o1[1]) + (o1[2] * o1[2] + o1[3] * o1[3]); }
                if (rowss) { ss += __shfl_xor(ss, 16); ss += __shfl_xor(ss, 32); if (fq == 0) rowss[(size_t)row * 16 + u.pn * 4 + wc] = ss; }
                asm volatile("" ::: "memory"); }
    }
};
struct EpiInProj {
    static constexpr bool PERM = true, AFTER_DRAIN = false;
    unsigned char* ws; const float* bgate;
    __device__ __forceinline__ void operator()(const f32x4 (&acc)[2][2][4][2], const Unit& u, int wr, int wc, int fr, int fq) const {
        float rs[2][4]; load_rstd(rs, (const float*)(ws + WSO_RSS), u.pm, wr, fr, fq);
        const int pn = u.pn;
        bf16_t *qsb = (bf16_t*)(ws + WSO_QSB), *ksb = (bf16_t*)(ws + WSO_KSB), *vsb = (bf16_t*)(ws + WSO_VSB), *qdl = (bf16_t*)(ws + WSO_QDL), *kdl = (bf16_t*)(ws + WSO_KDL), *vdl = (bf16_t*)(ws + WSO_VDL), *gates = (bf16_t*)(ws + WSO_GATES);
        const float* ropec = (const float*)(ws + WSO_ROPE); const float* ropes = ropec + SEQ * 32;
        if (pn < 6 || pn == 10) {
            bf16_t* base; int pitch, c0; float sc = 1.f;
            if (pn < 2) { base = qsb; pitch = SBW; c0 = pn * 256; sc = QSCALE; } else if (pn < 4) { base = ksb; pitch = SBW; c0 = (pn - 2) * 256; }
            else if (pn < 6) { base = vsb; pitch = SBW; c0 = (pn - 4) * 256; } else { base = vdl; pitch = DKVW; c0 = 0; }
#pragma unroll
            for (int ai = 0; ai < 2; ++ai)
#pragma unroll
                for (int m = 0; m < 4; ++m) { const int row = u.pm * BM + ai * HALF + wr * 64 + m * 16 + fr; const float r = rs[ai][m] * sc;
#pragma unroll
                    for (int bj = 0; bj < 2; ++bj) *(u32x4*)(base + (size_t)row * pitch + c0 + bj * HALF + wc * 32 + 8 * fq) = pack8(acc[ai][bj][m][0] * r, acc[ai][bj][m][1] * r); }
        } else if (pn < 10) {
            bf16_t* base; int pitch, c0; float sc = 1.f;
            if (pn < 9) { base = qdl; pitch = DQW; c0 = (pn - 6) * 256; sc = QSCALE; } else { base = kdl; pitch = DKVW; c0 = 0; }
#pragma unroll
            for (int ai = 0; ai < 2; ++ai)
#pragma unroll
                for (int m = 0; m < 4; ++m) { const int row = u.pm * BM + ai * HALF + wr * 64 + m * 16 + fr; const float r = rs[ai][m]; const int pos = row & (SEQ - 1);
                    f32x4 o1[2], o2[2];
#pragma unroll
                    for (int n = 0; n < 2; ++n) { const f32x4 c = *(const f32x4*)(ropec + pos * 32 + 8 * fq + 4 * n) * sc, s = *(const f32x4*)(ropes + pos * 32 + 8 * fq + 4 * n) * sc;
                        const f32x4 t1 = acc[ai][0][m][n] * r, t2 = acc[ai][1][m][n] * r; o1[n] = t1 * c - t2 * s; o2[n] = t2 * c + t1 * s; }
                    bf16_t* rp = base + (size_t)row * pitch + c0 + wc * 64 + 8 * fq;
                    *(u32x4*)(rp) = pack8(o1[0], o1[1]); *(u32x4*)(rp + 32) = pack8(o2[0], o2[1]);
                    asm volatile("" ::: "memory"); }
        } else {
            const int c0 = (pn - 11) * 256;
#pragma unroll
            for (int ai = 0; ai < 2; ++ai)
#pragma unroll
                for (int m = 0; m < 4; ++m) { const int row = u.pm * BM + ai * HALF + wr * 64 + m * 16 + fr; const float r = rs[ai][m];
#pragma unroll
                    for (int bj = 0; bj < 2; ++bj) { const int col = c0 + bj * HALF + wc * 32 + 8 * fq; f32x4 o[2];
#pragma unroll
                        for (int n = 0; n < 2; ++n) { const f32x4 v = acc[ai][bj][m][n] * r + *(const f32x4*)(bgate + col + 4 * n);
#pragma unroll
                            for (int e = 0; e < 4; ++e) o[n][e] = __builtin_amdgcn_rcpf(1.0f + __builtin_amdgcn_exp2f(-v[e] * LOG2E)); }
                        *(u32x4*)(gates + (size_t)row * 2048 + col) = pack8(o[0], o[1]); }
                    asm volatile("" ::: "memory"); }
        }
    }
};
template <bool SECOND> struct EpiGate {
    static constexpr bool PERM = true, AFTER_DRAIN = false;
    bf16_t* mbuf; const bf16_t* gates; int goff;
    __device__ __forceinline__ void operator()(const f32x4 (&acc)[2][2][4][2], const Unit& u, int wr, int wc, int fr, int fq) const {
#pragma unroll
        for (int ai = 0; ai < 2; ++ai)
#pragma unroll
            for (int m = 0; m < 4; ++m) { const int row = u.pm * BM + ai * HALF + wr * 64 + m * 16 + fr;
#pragma unroll
                for (int bj = 0; bj < 2; ++bj) { const int col = u.pn * BM + bj * HALF + wc * 32 + 8 * fq;
                    const u32x4 g = *(const u32x4*)(gates + (size_t)row * 2048 + goff + col);
                    f32x4 o0 = acc[ai][bj][m][0] * (f32x4){bf_lo(g.x), bf_hi(g.x), bf_lo(g.y), bf_hi(g.y)}, o1 = acc[ai][bj][m][1] * (f32x4){bf_lo(g.z), bf_hi(g.z), bf_lo(g.w), bf_hi(g.w)};
                    bf16_t* p = mbuf + (size_t)row * DMODEL + col;
                    if (SECOND) { const u32x4 t = *(const u32x4*)p; o0 += (f32x4){bf_lo(t.x), bf_hi(t.x), bf_lo(t.y), bf_hi(t.y)}; o1 += (f32x4){bf_lo(t.z), bf_hi(t.z), bf_lo(t.w), bf_hi(t.w)}; }
                    *(u32x4*)p = pack8(o0, o1); }
                asm volatile("" ::: "memory"); }
    }
};

template <class Epi, class Sched, bool ALIGN_EPI = false, bool SP2 = false>
__device__ __forceinline__ void gemm_phase(PG8_LAS unsigned char* lds, const Gemm g, const Sched& S, const Epi& E) {
    const int tid = threadIdx.x, wid = __builtin_amdgcn_readfirstlane(tid >> 6), lane = tid & 63, wr = wid >> 2, wc = wid & 3, fr = lane & 15, fq = lane >> 4;
    const int K = g.K, nt = K / BK;
    unsigned voffA[2], voffB[2];
#pragma unroll
    for (int i = 0; i < 2; ++i) { int R, C; stage_rc(tid * 16 + i * 8192, R, C); const int Rb = Epi::PERM ? ((R & ~31) + perm32(R & 31)) : R;
        voffA[i] = (unsigned)(R * K + C) * 2u; voffB[i] = (unsigned)(Rb * K + C) * 2u; }
    const size_t kstep = (size_t)(BK * 2);
    const size_t hstep = (size_t)HALF * K * 2;
    const size_t tstep = 2 * hstep;
    const unsigned ldsw = (unsigned)wid * 1024u;
    const int aoff = lds_byte(wr * 64 + fr, fq * 8), boff = lds_byte(wc * 32 + fr, fq * 8);
#define PG8_SA(b, h) (((b) * 2 + (h)) * HTB)
#define PG8_SB(b, h) ((4 + (b) * 2 + (h)) * HTB)
#define PG8_STAGE(bufoff, gbase, voff) do { _Pragma("unroll") for (int _i = 0; _i < 2; ++_i) \
        __builtin_amdgcn_global_load_lds((const unsigned*)((const char*)(gbase) + (voff)[_i]), (PG8_LAS unsigned*)(lds + (bufoff) + ldsw + _i * 8192), 16, 0, 0); } while (0)
#define PG8_LDA(dst, b, h) do { _Pragma("unroll") for (int m = 0; m < 4; ++m) _Pragma("unroll") for (int k = 0; k < 2; ++k) dst[m][k] = *(const PG8_LAS bf16x8*)(lds + PG8_SA(b, h) + aoff + m * 2048 + k * 1024); } while (0)
#define PG8_LDB(dst, b, h) do { _Pragma("unroll") for (int n = 0; n < 2; ++n) _Pragma("unroll") for (int k = 0; k < 2; ++k) dst[n][k] = *(const PG8_LAS bf16x8*)(lds + PG8_SB(b, h) + boff + n * 2048 + k * 1024); } while (0)
#define PG8_MMA(ai, bj, At, Bt) do { __builtin_amdgcn_s_setprio(1); _Pragma("unroll") for (int m = 0; m < 4; ++m) _Pragma("unroll") for (int n = 0; n < 2; ++n) _Pragma("unroll") for (int k = 0; k < 2; ++k) \
        acc[ai][bj][m][n] = __builtin_amdgcn_mfma_f32_16x16x32_bf16(Bt[n][k], At[m][k], acc[ai][bj][m][n], 0, 0, 0); __builtin_amdgcn_s_setprio(0); } while (0)
#define PG8_WAIT_V(n) asm volatile("s_waitcnt vmcnt(" #n ")" ::: "memory")
#define PG8_WAIT_L(n) asm volatile("s_waitcnt lgkmcnt(" #n ")" ::: "memory")
#define PG8_BAR __builtin_amdgcn_s_barrier()
#define PG8_SCHED __builtin_amdgcn_sched_barrier(0)
    Unit cur, nxt; int ui = 0;
    if (!S.next(0, cur)) return;
    f32x4 acc[2][2][4][2];
#pragma unroll
    for (int a = 0; a < 2; ++a)
#pragma unroll
        for (int b = 0; b < 2; ++b)
#pragma unroll
            for (int m = 0; m < 4; ++m)
#pragma unroll
                for (int n = 0; n < 2; ++n) acc[a][b][m][n] = (f32x4){0.f, 0.f, 0.f, 0.f};
    bf16x8 At[4][2], B0[2][2], B1[2][2];
    const char* cA = (const char*)g.A + (size_t)cur.pm * tstep; const char* cB = (const char*)g.Bt + (size_t)cur.pn * tstep;
    S.a_ready(cur);
    if constexpr (SP2) {
        PG8_STAGE(PG8_SB(0, 0), cB, voffB); PG8_STAGE(PG8_SB(0, 1), cB + hstep, voffB); PG8_STAGE(PG8_SA(0, 0), cA, voffA); PG8_STAGE(PG8_SA(0, 1), cA + hstep, voffA);
        if (wr == 1) PG8_BAR;
        PG8_WAIT_V(2); PG8_BAR;
        PG8_STAGE(PG8_SB(1, 0), cB + kstep, voffB); PG8_STAGE(PG8_SA(1, 0), cA + kstep, voffA); PG8_STAGE(PG8_SB(1, 1), cB + hstep + kstep, voffB);
        PG8_WAIT_V(6); PG8_BAR;
    } else {
        PG8_STAGE(PG8_SB(0, 0), cB, voffB); PG8_STAGE(PG8_SA(0, 0), cA, voffA); PG8_STAGE(PG8_SB(0, 1), cB + hstep, voffB); PG8_STAGE(PG8_SA(0, 1), cA + hstep, voffA);
        if (wr == 1) PG8_BAR;
        PG8_WAIT_V(4); PG8_BAR;
        PG8_STAGE(PG8_SB(1, 0), cB + kstep, voffB); PG8_STAGE(PG8_SA(1, 0), cA + kstep, voffA); PG8_STAGE(PG8_SB(1, 1), cB + hstep + kstep, voffB);
        PG8_WAIT_V(6); PG8_BAR;
    }
    for (;;) {
        const bool has_next = S.next(ui + 1, nxt);
        const char* nA = has_next ? (const char*)g.A + (size_t)nxt.pm * tstep : cA; const char* nB = has_next ? (const char*)g.Bt + (size_t)nxt.pn * tstep : cB;
        for (int t = 0; t < nt; t += 2) {
            const bool last = (t == nt - 2);
            const char* a1 = cA + (size_t)(t + 1) * kstep;
            const char* a2 = last ? nA : cA + (size_t)(t + 2) * kstep; const char* b2 = last ? nB : cB + (size_t)(t + 2) * kstep;
            const char* a3 = a2 + kstep; const char* b3 = b2 + kstep;
            if (last && has_next) S.a_ready(nxt);
            if constexpr (SP2) {
            PG8_LDB(B0, 0, 0); PG8_LDB(B1, 0, 1); PG8_SCHED; PG8_LDA(At, 0, 0); PG8_STAGE(PG8_SA(1, 1), a1 + hstep, voffA);
            PG8_WAIT_V(8); PG8_WAIT_L(0); PG8_BAR; PG8_MMA(0, 0, At, B0); PG8_MMA(0, 1, At, B1); PG8_BAR; PG8_SCHED;
            PG8_LDA(At, 0, 1); PG8_STAGE(PG8_SB(0, 0), b2, voffB); PG8_STAGE(PG8_SB(0, 1), b2 + hstep, voffB); PG8_STAGE(PG8_SA(0, 0), a2, voffA);
            PG8_WAIT_V(8); PG8_WAIT_L(0); PG8_BAR; PG8_MMA(1, 0, At, B0); PG8_MMA(1, 1, At, B1); PG8_BAR; PG8_SCHED;
            PG8_LDB(B0, 1, 0); PG8_LDB(B1, 1, 1); PG8_SCHED; PG8_LDA(At, 1, 0); PG8_STAGE(PG8_SA(0, 1), a2 + hstep, voffA);
            PG8_WAIT_V(8); PG8_WAIT_L(0); PG8_BAR; PG8_MMA(0, 0, At, B0); PG8_MMA(0, 1, At, B1); PG8_BAR; PG8_SCHED;
            PG8_LDA(At, 1, 1); PG8_STAGE(PG8_SB(1, 0), b3, voffB); PG8_STAGE(PG8_SB(1, 1), b3 + hstep, voffB); PG8_STAGE(PG8_SA(1, 0), a3, voffA);
            PG8_WAIT_V(8); PG8_WAIT_L(0); PG8_BAR; PG8_MMA(1, 0, At, B0); PG8_MMA(1, 1, At, B1); PG8_BAR; PG8_SCHED;
            } else {
            PG8_LDB(B0, 0, 0); PG8_SCHED; PG8_LDA(At, 0, 0); PG8_STAGE(PG8_SA(1, 1), a1 + hstep, voffA);
            PG8_WAIT_L(8); PG8_BAR; PG8_WAIT_L(0); PG8_MMA(0, 0, At, B0); PG8_BAR; PG8_SCHED;
            PG8_LDB(B1, 0, 1); PG8_STAGE(PG8_SB(0, 0), b2, voffB);
            PG8_BAR; PG8_WAIT_L(0); PG8_MMA(0, 1, At, B1); PG8_BAR;
            PG8_LDA(At, 0, 1); PG8_STAGE(PG8_SA(0, 0), a2, voffA);
            PG8_BAR; PG8_WAIT_L(0); PG8_MMA(1, 0, At, B0); PG8_BAR; PG8_SCHED;
            PG8_STAGE(PG8_SB(0, 1), b2 + hstep, voffB);
            PG8_WAIT_V(6); PG8_BAR; PG8_MMA(1, 1, At, B1); PG8_BAR;
            PG8_LDB(B0, 1, 0); PG8_SCHED; PG8_LDA(At, 1, 0); PG8_STAGE(PG8_SA(0, 1), a2 + hstep, voffA);
            PG8_WAIT_L(8); PG8_BAR; PG8_WAIT_L(0); PG8_MMA(0, 0, At, B0); PG8_BAR; PG8_SCHED;
            PG8_LDB(B1, 1, 1); PG8_STAGE(PG8_SB(1, 0), b3, voffB);
            PG8_BAR; PG8_WAIT_L(0); PG8_MMA(0, 1, At, B1); PG8_BAR;
            PG8_LDA(At, 1, 1); PG8_STAGE(PG8_SA(1, 0), a3, voffA);
            PG8_BAR; PG8_WAIT_L(0); PG8_MMA(1, 0, At, B0); PG8_BAR; PG8_SCHED;
            PG8_STAGE(PG8_SB(1, 1), b3 + hstep, voffB);
            PG8_WAIT_V(6); PG8_BAR; PG8_MMA(1, 1, At, B1); PG8_BAR;
            }
        }
        if constexpr (ALIGN_EPI) { if (wr == 0) PG8_BAR; }
        if constexpr (!Epi::AFTER_DRAIN) { E(acc, cur, wr, wc, fr, fq); S.done(cur); }
        if (!has_next) break;
#pragma unroll
        for (int a = 0; a < 2; ++a)
#pragma unroll
            for (int b = 0; b < 2; ++b)
#pragma unroll
                for (int m = 0; m < 4; ++m)
#pragma unroll
                    for (int n = 0; n < 2; ++n) acc[a][b][m][n] = (f32x4){0.f, 0.f, 0.f, 0.f};
        cur = nxt; cA = nA; cB = nB; ++ui;
        if constexpr (ALIGN_EPI) { if (wr == 1) PG8_BAR; }
    }
    PG8_WAIT_V(0);
    if constexpr (!ALIGN_EPI) { if (wr == 0) PG8_BAR; }
    PG8_BAR;
    if constexpr (Epi::AFTER_DRAIN) { E.fused(acc, cur, wr, wc, fr, fq, lds, wid, lane); S.done(cur); }
#undef PG8_SA
#undef PG8_SB
#undef PG8_STAGE
#undef PG8_LDA
#undef PG8_LDB
#undef PG8_MMA
#undef PG8_WAIT_V
#undef PG8_WAIT_L
#undef PG8_BAR
#undef PG8_SCHED
}
}
#define LAS __attribute__((address_space(3)))
typedef unsigned short bf16;
typedef unsigned v4u __attribute__((ext_vector_type(4)));
typedef float f32x4 __attribute__((ext_vector_type(4)));
typedef short s16x8 __attribute__((ext_vector_type(8)));
typedef float f32x16 __attribute__((ext_vector_type(16)));
#define LDS_WAIT() asm volatile("s_waitcnt lgkmcnt(0)" ::: "memory")
constexpr int NWAVES = 8, NTHREADS = 512;
constexpr int RING_BYTES = 131072, LDS_BYTES = 147456;
constexpr size_t MiB = 1u << 20, HMiB = 1u << 19;
constexpr size_t WS_W13A = 0, WS_W2A = 11 * MiB, WS_WIN = 33 * HMiB, WS_WSB = 26 * MiB, WS_WDIL = 27 * MiB, WS_WO = 55 * HMiB, WS_W13B = 59 * HMiB, WS_W2B = 81 * HMiB;
constexpr size_t WS_ROPE = 46 * MiB, WS_RSS = 48 * MiB, WS_YDL = 49 * MiB, WS_XB = 57 * MiB;
constexpr size_t WS_U = 89 * MiB;
constexpr size_t WS_QSB = 89 * MiB, WS_KSB = 105 * MiB, WS_VSB = 121 * MiB, WS_QDL = 137 * MiB, WS_KDL = 161 * MiB, WS_VDL = 169 * MiB, WS_GATES = 177 * MiB;
constexpr size_t WS_MBUF = WS_KSB;
constexpr size_t WS_LSE = 241 * MiB, WS_CTL = 242 * MiB, WS_END = 243 * MiB;
static_assert(WS_ROPE == WSO_ROPE && WS_RSS == WSO_RSS && WS_QSB == WSO_QSB && WS_KSB == WSO_KSB && WS_VSB == WSO_VSB && WS_QDL == WSO_QDL && WS_KDL == WSO_KDL && WS_VDL == WSO_VDL && WS_GATES == WSO_GATES, "d_ws map");
static_assert(WS_W13A + (size_t)2 * DFF * DMODEL * 2 == WS_W2A && WS_W2A + (size_t)DMODEL * DFF * 2 == WS_WIN && WS_WIN + (size_t)INW * DMODEL * 2 == WS_WSB && WS_WO + (size_t)DMODEL * DMODEL * 2 == WS_W13B
              && WS_W13B + (size_t)2 * DFF * DMODEL * 2 == WS_W2B && WS_W2B + (size_t)DMODEL * DFF * 2 == WS_ROPE && WS_U + (size_t)MTOK * DFF * 2 == WS_GATES && WS_GATES + (size_t)MTOK * 2048 * 2 == WS_LSE, "d_ws map");

__device__ __forceinline__ unsigned f2bf(float f) { unsigned u = __builtin_bit_cast(unsigned, f); return (u + 0x7fffu + ((u >> 16) & 1u)) >> 16; }
__device__ __forceinline__ unsigned pk2(float lo, float hi) { return f2bf(lo) | (f2bf(hi) << 16); }
__device__ __forceinline__ float wave_sum(float v) {
#pragma unroll
    for (int o = 1; o < 64; o <<= 1) v += __shfl_xor(v, o);
    return v;
}
__device__ __forceinline__ void transpose_item(const float* W, int N, const float* g, bf16* WT, int Kd, int k0, int n0, int drow0, LAS float* scr, int lane) {
#pragma unroll 8
    for (int i = 0; i < 32; ++i) { const int kk = 2 * i + (lane >> 5); float v = W[(size_t)(k0 + kk) * N + n0 + (lane & 31)]; if (g) v *= g[k0 + kk]; scr[kk * 33 + (lane & 31)] = v; }
    LDS_WAIT(); asm volatile("" ::: "memory");
    const int c = lane & 7;
#pragma unroll
    for (int j = 0; j < 4; ++j) { const int n = (lane >> 3) + 8 * j; const LAS float* s = scr + (8 * c) * 33 + n;
        v4u o; o.x = pk2(s[0 * 33], s[1 * 33]); o.y = pk2(s[2 * 33], s[3 * 33]); o.z = pk2(s[4 * 33], s[5 * 33]); o.w = pk2(s[6 * 33], s[7 * 33]);
        *(v4u*)(WT + (size_t)(drow0 + n) * Kd + k0 + 8 * c) = o; }
    LDS_WAIT(); asm volatile("" ::: "memory");
}
struct Ptrs {
    const float *x, *g_ffn1, *w1_a, *w3_a, *w2_a, *g_mix, *w_in, *b_gate, *w_sb_out, *w_dil_out, *w_o, *g_ffn2, *w1_b, *w3_b, *w2_b, *g_final;
    float* out; unsigned char* ws;
};
__device__ __forceinline__ void p0_prologue(const Ptrs& P, LAS unsigned char* lds, int gw, int NGW, int wave, int lane) {
    LAS float* scr = (LAS float*)(lds + wave * 16384);
    unsigned char* ws = P.ws;
    constexpr int I_UP = (DMODEL / 64) * (DFF / 32), I_DN = (DFF / 64) * (DMODEL / 32), I_IN = (DMODEL / 64) * (INW / 32), I_SB = (SBW / 64) * (DMODEL / 32), I_DL = (DKVW / 64) * (DMODEL / 32), I_O = (DMODEL / 64) * (DMODEL / 32);
    constexpr int NITEMS = 4 * I_UP + 2 * I_DN + I_IN + I_SB + I_DL + I_O;
    for (int it = gw; it < NITEMS; it += NGW) {
        int r = it;
        if (r < 4 * I_UP) {
            const int which = r / I_UP; r -= which * I_UP; const int nblk = DFF / 32, k0 = 64 * (r / nblk), n0 = 32 * (r % nblk);
            const float* W = which == 0 ? P.w1_a : which == 1 ? P.w3_a : which == 2 ? P.w1_b : P.w3_b;
            bf16* WT = (bf16*)(ws + (which < 2 ? WS_W13A : WS_W13B));
            transpose_item(W, DFF, which < 2 ? P.g_ffn1 : P.g_ffn2, WT, DMODEL, k0, n0, 256 * (n0 / 128) + 128 * (which & 1) + (n0 % 128), scr, lane); continue; }
        r -= 4 * I_UP;
        if (r < 2 * I_DN) { const int which = r / I_DN; r -= which * I_DN; const int nblk = DMODEL / 32, k0 = 64 * (r / nblk), n0 = 32 * (r % nblk);
            transpose_item(which ? P.w2_b : P.w2_a, DMODEL, nullptr, (bf16*)(ws + (which ? WS_W2B : WS_W2A)), DFF, k0, n0, n0, scr, lane); continue; }
        r -= 2 * I_DN;
        if (r < I_IN) { const int nblk = INW / 32, k0 = 64 * (r / nblk), n0 = 32 * (r % nblk); int drow = n0;
            if (n0 >= 1536 && n0 < 2560) { const int a0 = n0 & 255; drow = (n0 & ~255) + 128 * ((a0 >> 5) & 1) + 32 * (a0 >> 6); }
            transpose_item(P.w_in, INW, P.g_mix, (bf16*)(ws + WS_WIN), DMODEL, k0, n0, drow, scr, lane); continue; }
        r -= I_IN;
        if (r < I_SB) { const int nblk = DMODEL / 32, k0 = 64 * (r / nblk), n0 = 32 * (r % nblk); transpose_item(P.w_sb_out, DMODEL, nullptr, (bf16*)(ws + WS_WSB), SBW, k0, n0, n0, scr, lane); continue; }
        r -= I_SB;
        if (r < I_DL) { const int nblk = DMODEL / 32, k0 = 64 * (r / nblk), n0 = 32 * (r % nblk); transpose_item(P.w_dil_out, DMODEL, nullptr, (bf16*)(ws + WS_WDIL), DKVW, k0, n0, n0, scr, lane); continue; }
        r -= I_DL;
        { const int nblk = DMODEL / 32, k0 = 64 * (r / nblk), n0 = 32 * (r % nblk); transpose_item(P.w_o, DMODEL, nullptr, (bf16*)(ws + WS_WO), DMODEL, k0, n0, n0, scr, lane); }
    }
    bf16* xb = (bf16*)(ws + WS_XB); float* rowss = (float*)(ws + WS_RSS);
    for (int m = gw; m < MTOK; m += NGW) {
        const f32x4* xr = (const f32x4*)(P.x + (size_t)m * DMODEL) + lane; f32x4 v[4]; float s = 0.f;
#pragma unroll
        for (int j = 0; j < 4; ++j) { v[j] = xr[64 * j]; s += (v[j].x * v[j].x + v[j].y * v[j].y) + (v[j].z * v[j].z + v[j].w * v[j].w); }
        s = wave_sum(s);
        unsigned long long* o8 = (unsigned long long*)(xb + (size_t)m * DMODEL) + lane;
#pragma unroll
        for (int j = 0; j < 4; ++j) o8[64 * j] = (unsigned long long)pk2(v[j].x, v[j].y) | ((unsigned long long)pk2(v[j].z, v[j].w) << 32);
        if (lane < 16) rowss[(size_t)m * 16 + lane] = lane == 0 ? s : 0.f;
    }
    float* ropec = (float*)(ws + WS_ROPE); float* ropes = ropec + SEQ * 32;
    for (int e = gw * 64 + lane; e < SEQ * 32; e += NGW * 64) { const int pos = e >> 5, i = e & 31;
        const float invf = powf(10000.0f, -(float)i / 32.0f); const float ang = (float)pos * invf;
        double rev = (double)ang * 0.15915494309189535; rev -= __builtin_rint(rev); const float fr = (float)rev;
        ropec[e] = __builtin_amdgcn_cosf(fr); ropes[e] = __builtin_amdgcn_sinf(fr); }
}
__device__ __forceinline__ int crow(int r, int hi) { return (r & 3) + 8 * (r >> 2) + 4 * hi; }
__device__ __forceinline__ unsigned cvtpk(float lo, float hi) { unsigned r; asm volatile("v_cvt_pk_bf16_f32 %0, %1, %2" : "=v"(r) : "v"(lo), "v"(hi)); return r; }
__device__ __forceinline__ s16x8 pack_p(const f32x16& p, int c) { v4u w; w.x = cvtpk(p[8 * c + 0], p[8 * c + 1]); w.y = cvtpk(p[8 * c + 2], p[8 * c + 3]); w.z = cvtpk(p[8 * c + 4], p[8 * c + 5]); w.w = cvtpk(p[8 * c + 6], p[8 * c + 7]); return __builtin_bit_cast(s16x8, w); }
constexpr int VT_PITCH = 72, VT_BYTES = 32 * VT_PITCH * 2;
struct VRegs { s16x8 t[4]; };
__device__ __forceinline__ void vload(VRegs& v, const bf16* vsrc  , unsigned rstride, int lane) {
    const bf16* p = vsrc + (size_t)((unsigned)(lane >> 1) * rstride + (unsigned)(lane & 1) * 32u);
#pragma unroll
    for (int i = 0; i < 4; ++i) v.t[i] = *(const s16x8*)(p + 8 * i);
}
__device__ __forceinline__ void vfrags(s16x8 (&vf)[2][2], const VRegs& v, LAS bf16* vt, int lane) {
    const int r32 = lane & 31, hi = lane >> 5;
    asm volatile("s_waitcnt lgkmcnt(0)" ::: "memory");
    LAS bf16* wp = vt + (lane >> 1) * VT_PITCH + (lane & 1) * 32;
#pragma unroll
    for (int i = 0; i < 4; ++i) *(LAS s16x8*)(wp + 8 * i) = v.t[i];
    asm volatile("s_waitcnt lgkmcnt(0)" ::: "memory");
    const LAS bf16* rp = vt + 4 * hi * VT_PITCH + r32;
#pragma unroll
    for (int c = 0; c < 2; ++c)
#pragma unroll
        for (int e = 0; e < 8; ++e) { const int key = ((8 * c + e) & 3) + 8 * ((8 * c + e) >> 2); vf[0][c][e] = (short)rp[key * VT_PITCH]; vf[1][c][e] = (short)rp[key * VT_PITCH + 32]; }
}
__device__ __forceinline__ void store_o(bf16* ob  , unsigned rstride, const f32x16& o0, const f32x16& o1, LAS bf16* vt, int lane) {
    const int r32 = lane & 31, hi = lane >> 5;
    asm volatile("s_waitcnt lgkmcnt(0)" ::: "memory");
    LAS bf16* wp = vt + 4 * hi * VT_PITCH + r32;
#pragma unroll
    for (int r = 0; r < 16; ++r) { const int row = (r & 3) + 8 * (r >> 2); wp[row * VT_PITCH] = (bf16)f2bf(o0[r]); wp[row * VT_PITCH + 32] = (bf16)f2bf(o1[r]); }
    asm volatile("s_waitcnt lgkmcnt(0)" ::: "memory");
    const LAS bf16* rp = vt + (lane >> 1) * VT_PITCH + (lane & 1) * 32;
    bf16* gp = ob + (size_t)((unsigned)(lane >> 1) * rstride + (unsigned)(lane & 1) * 32u);
#pragma unroll
    for (int i = 0; i < 4; ++i) *(s16x8*)(gp + 8 * i) = *(const LAS s16x8*)(rp + 8 * i);
}
__device__ __forceinline__ void kload(s16x8 (&kf)[4], const bf16* ksrc  , unsigned rstride, int lane) {
    const bf16* p = ksrc + (size_t)((unsigned)(lane & 31) * rstride + (unsigned)(lane >> 5) * 8u);
#pragma unroll
    for (int d0 = 0; d0 < 4; ++d0) kf[d0] = *(const s16x8*)(p + 16 * d0);
}
__device__ __forceinline__ void sb_item(int item, bf16* QO, const bf16* K, const bf16* V, LAS bf16* vt, int lane) {
    const int r32 = lane & 31, hi = lane >> 5;
    const int qb = 255 - (item & 255), h = (item >> 8) & 7, b = item >> 11;
    const int t0 = qb * 32; const size_t rowb = (size_t)b * SEQ;
    s16x8 qr[4]; kload(qr, QO + (rowb + t0) * SBW + h * 64, SBW, lane);
    const bf16* Kh = K + rowb * SBW + h * 64; const bf16* Vh = V + rowb * SBW + h * 64;
    f32x16 o0 = {}, o1 = {}; float carry = 0.f;
    s16x8 kn[4]; VRegs vn; kload(kn, Kh + (size_t)t0 * SBW, SBW, lane); vload(vn, Vh + (size_t)t0 * SBW, SBW, lane);
    for (int kb = t0; kb >= 0; kb -= 32) {
        s16x8 kf[4]; VRegs vc;
#pragma unroll
        for (int d0 = 0; d0 < 4; ++d0) { kf[d0] = kn[d0]; vc.t[d0] = vn.t[d0]; }
        if (kb >= 32) { kload(kn, Kh + (size_t)(kb - 32) * SBW, SBW, lane); vload(vn, Vh + (size_t)(kb - 32) * SBW, SBW, lane); }
        f32x16 s = {};
#pragma unroll
        for (int d0 = 0; d0 < 4; ++d0) s = __builtin_amdgcn_mfma_f32_32x32x16_bf16(kf[d0], qr[d0], s, 0, 0, 0);
        const bool diag = (kb == t0);
        int lim = diag ? r32 - 4 * hi : 64; asm volatile("" : "+v"(lim));
        float ls[16], ln[16];
#pragma unroll
        for (int r = 0; r < 16; ++r) { const float z = s[r]; const float lp = __builtin_amdgcn_logf(1.0f + __builtin_amdgcn_exp2f(-__builtin_fabsf(z)));
            ls[r] = __builtin_fminf(z, 0.f) - lp; ln[r] = __builtin_fminf(-z, 0.f) - lp;
            if (!(((r & 3) + 8 * (r >> 2)) < lim)) { ln[r] = 0.f; ls[r] = -INFINITY; } }
        float tot[4], pg[4];
#pragma unroll
        for (int g = 0; g < 4; ++g) { const float gs = (ln[4 * g] + ln[4 * g + 1]) + (ln[4 * g + 2] + ln[4 * g + 3]); pg[g] = __shfl_xor(gs, 32); tot[g] = gs + pg[g]; }
        float T[4]; T[3] = 0.f; T[2] = tot[3]; T[1] = T[2] + tot[2]; T[0] = T[1] + tot[1]; const float total = T[0] + tot[0];
        f32x16 a;
#pragma unroll
        for (int g = 0; g < 4; ++g) { const float w3 = carry + T[g] + (hi == 0 ? pg[g] : 0.f), w2 = w3 + ln[4 * g + 3], w1 = w2 + ln[4 * g + 2], w0 = w1 + ln[4 * g + 1];
            a[4 * g + 0] = __builtin_amdgcn_exp2f(ls[4 * g + 0] + w0); a[4 * g + 1] = __builtin_amdgcn_exp2f(ls[4 * g + 1] + w1);
            a[4 * g + 2] = __builtin_amdgcn_exp2f(ls[4 * g + 2] + w2); a[4 * g + 3] = __builtin_amdgcn_exp2f(ls[4 * g + 3] + w3); }
        carry += total;
        const s16x8 pa0 = pack_p(a, 0), pa1 = pack_p(a, 1);
        s16x8 vf[2][2]; vfrags(vf, vc, vt, lane);
        o0 = __builtin_amdgcn_mfma_f32_32x32x16_bf16(pa0, vf[0][0], o0, 0, 0, 0); o0 = __builtin_amdgcn_mfma_f32_32x32x16_bf16(pa1, vf[0][1], o0, 0, 0, 0);
        o1 = __builtin_amdgcn_mfma_f32_32x32x16_bf16(pa0, vf[1][0], o1, 0, 0, 0); o1 = __builtin_amdgcn_mfma_f32_32x32x16_bf16(pa1, vf[1][1], o1, 0, 0, 0);
        if (__all(carry < -150.0f)) break;
    }
    store_o(QO + (rowb + t0) * SBW + h * 64, SBW, o0, o1, vt, lane);
}
__device__ __forceinline__ void dl_item(int item, bf16* QO, const bf16* K, const bf16* V, float* LSE, LAS bf16* vt, int lane) {
    const int r32 = lane & 31, hi = lane >> 5;
    const int g = item >> 11, rem = item & 2047, b = rem >> 10, j = (rem >> 8) & 3, blk = rem & 255;
    const int dsh = 2 * g, dil = 1 << dsh, nsb = 256 >> dsh, rr = blk / nsb, i0 = (blk % nsb) * 32;
    const size_t rowb = (size_t)b * SEQ + rr;
    const unsigned qstride = (unsigned)dil * DQW, kstride = (unsigned)dil * DKVW;
    bf16* Qb = QO + (rowb + (size_t)dil * i0) * DQW + (g * 4 + j) * 64;
    s16x8 qr[4]; kload(qr, Qb, qstride, lane);
    const bf16* Kh = K + rowb * DKVW + j * 64; const bf16* Vh = V + rowb * DKVW + j * 64;
    f32x16 sc[5]; float mx = -INFINITY; const float flim = (float)(r32 - 4 * hi);
#pragma unroll
    for (int n = 0; n < 5; ++n) { const int kbi = i0 - 128 + 32 * n;
        if (kbi >= 0) {
            s16x8 kf[4]; kload(kf, Kh + (size_t)kbi * kstride, kstride, lane);
            f32x16 s = {};
#pragma unroll
            for (int d0 = 0; d0 < 4; ++d0) s = __builtin_amdgcn_mfma_f32_32x32x16_bf16(kf[d0], qr[d0], s, 0, 0, 0);
#pragma unroll
            for (int r = 0; r < 16; ++r) {
                if (n == 0) s[r] = __builtin_fminf(s[r], ((float)((r & 3) + 8 * (r >> 2)) - flim + 0.5f) * 6e38f);
                if (n == 4) s[r] = __builtin_fminf(s[r], (flim - (float)((r & 3) + 8 * (r >> 2)) + 0.5f) * 6e38f);
                mx = __builtin_fmaxf(mx, s[r]); }
            sc[n] = s;
        } else {
#pragma unroll
            for (int r = 0; r < 16; ++r) sc[n][r] = -INFINITY;
        }
    }
    mx = __builtin_fmaxf(mx, __shfl_xor(mx, 32));
    float l = 0.f;
#pragma unroll
    for (int n = 0; n < 5; ++n)
#pragma unroll
        for (int r = 0; r < 16; ++r) { const float p = __builtin_amdgcn_exp2f(sc[n][r] - mx); sc[n][r] = p; l += p; }
    l += __shfl_xor(l, 32);
    const float inv = 1.0f / l;
    f32x16 o0 = {}, o1 = {};
#pragma unroll
    for (int n = 0; n < 5; ++n) { const int kbi = i0 - 128 + 32 * n;
        if (kbi >= 0) {
            VRegs vc; vload(vc, Vh + (size_t)kbi * kstride, kstride, lane);
            f32x16 p = sc[n] * inv;
            const s16x8 pa0 = pack_p(p, 0), pa1 = pack_p(p, 1);
            s16x8 vf[2][2]; vfrags(vf, vc, vt, lane);
            o0 = __builtin_amdgcn_mfma_f32_32x32x16_bf16(pa0, vf[0][0], o0, 0, 0, 0); o0 = __builtin_amdgcn_mfma_f32_32x32x16_bf16(pa1, vf[0][1], o0, 0, 0, 0);
            o1 = __builtin_amdgcn_mfma_f32_32x32x16_bf16(pa0, vf[1][0], o1, 0, 0, 0); o1 = __builtin_amdgcn_mfma_f32_32x32x16_bf16(pa1, vf[1][1], o1, 0, 0, 0);
        }
    }
    store_o(Qb, qstride, o0, o1, vt, lane);
    if (hi == 0) LSE[((size_t)g * MTOK + rowb + (size_t)dil * (i0 + r32)) * 4 + j] = mx + __builtin_amdgcn_logf(l);
}
__device__ __forceinline__ void combine_rows(int pm, const bf16* O, const float* LSE, bf16* YDL, int tid) {
#pragma unroll 4
    for (int k = 0; k < 16; ++k) { const int c = tid + NTHREADS * k, row = pm * 256 + (c >> 5), cc = c & 31, j = cc >> 3;
        const float l0 = LSE[((size_t)0 * MTOK + row) * 4 + j], l1 = LSE[((size_t)1 * MTOK + row) * 4 + j], l2 = LSE[((size_t)2 * MTOK + row) * 4 + j];
        const float M = __builtin_fmaxf(l0, __builtin_fmaxf(l1, l2)); float w0 = __builtin_amdgcn_exp2f(l0 - M), w1 = __builtin_amdgcn_exp2f(l1 - M), w2 = __builtin_amdgcn_exp2f(l2 - M);
        const float inv = 1.0f / (w0 + w1 + w2); w0 *= inv; w1 *= inv; w2 *= inv;
        const bf16* op = O + (size_t)row * DQW + cc * 8;
        const v4u a = *(const v4u*)op, bq = *(const v4u*)(op + 256), cq = *(const v4u*)(op + 512);
        v4u o;
#define CMB(x) pk2(w0 * pg8::bf_lo(a.x) + w1 * pg8::bf_lo(bq.x) + w2 * pg8::bf_lo(cq.x), w0 * pg8::bf_hi(a.x) + w1 * pg8::bf_hi(bq.x) + w2 * pg8::bf_hi(cq.x))
        o.x = CMB(x); o.y = CMB(y); o.z = CMB(z); o.w = CMB(w);
#undef CMB
        *(v4u*)(YDL + (size_t)row * DKVW + cc * 8) = o; }
}

__device__ __forceinline__ void grid_bar(unsigned* ctr, unsigned target) {
    asm volatile("s_waitcnt vmcnt(0)" ::: "memory");
    __syncthreads();
    if (threadIdx.x == 0) {
        __builtin_amdgcn_fence(__ATOMIC_RELEASE, "agent");
        asm volatile("s_waitcnt vmcnt(0)" ::: "memory");
        __hip_atomic_fetch_add(ctr, 1u, __ATOMIC_RELAXED, __HIP_MEMORY_SCOPE_AGENT);
        unsigned spins = 0;
        while (__hip_atomic_load(ctr, __ATOMIC_RELAXED, __HIP_MEMORY_SCOPE_AGENT) < target) { __builtin_amdgcn_s_sleep(2); if (++spins > (1u << 24)) break; }
        __builtin_amdgcn_fence(__ATOMIC_ACQUIRE, "agent");
        asm volatile("s_waitcnt vmcnt(0)" ::: "memory");
    }
    __syncthreads();
}
struct Args { const float* in[16]; float* out; unsigned char* ws; int ph_lo, ph_hi, coop, pad; };
constexpr int NPHASES = 10;
__global__ void __launch_bounds__(NTHREADS, 2) mk_fwd(Args args) {
    extern __shared__ __attribute__((aligned(16))) unsigned char lds_raw[];
    LAS unsigned char* lds = (LAS unsigned char*)lds_raw;
    cg::grid_group grid = cg::this_grid();
    const int tid = threadIdx.x, lane = tid & 63, wave = __builtin_amdgcn_readfirstlane(tid >> 6);
    const int G = gridDim.x, gw = blockIdx.x * NWAVES + wave, NGW = G * NWAVES;
    unsigned char* ws = args.ws;
#define xb ((bf16*)(ws + WS_XB))
#define rowss ((float*)(ws + WS_RSS))
#define U ((bf16*)(ws + WS_U))
#define qsb ((bf16*)(ws + WS_QSB))
#define ksb ((bf16*)(ws + WS_KSB))
#define vsb ((bf16*)(ws + WS_VSB))
#define qdl ((bf16*)(ws + WS_QDL))
#define kdl ((bf16*)(ws + WS_KDL))
#define vdl ((bf16*)(ws + WS_VDL))
#define gates ((bf16*)(ws + WS_GATES))
#define mbuf ((bf16*)(ws + WS_MBUF))
#define ydl ((bf16*)(ws + WS_YDL))
#define lse ((float*)(ws + WS_LSE))
    const int lo = args.ph_lo, hi = args.ph_hi;
#ifndef PHMASK
#define PHMASK 0x3ff
#endif
#define IN(k) (((PHMASK >> (k)) & 1) && lo <= (k) && (k) < hi)
#define SEAM(k) do { if (IN(k) && IN((k) + 1)) { if (args.coop) { if ((k) == 0) grid.sync(); else grid_bar((unsigned*)(ws + WS_CTL), (unsigned)(k) * (unsigned)G); } } } while (0)

    if (IN(0)) { Ptrs P; P.x = args.in[0]; P.g_ffn1 = args.in[1]; P.w1_a = args.in[2]; P.w3_a = args.in[3]; P.w2_a = args.in[4]; P.g_mix = args.in[5]; P.w_in = args.in[6]; P.b_gate = args.in[7];
        P.w_sb_out = args.in[8]; P.w_dil_out = args.in[9]; P.w_o = args.in[10]; P.g_ffn2 = args.in[11]; P.w1_b = args.in[12]; P.w3_b = args.in[13]; P.w2_b = args.in[14]; P.g_final = args.in[15]; P.out = args.out; P.ws = ws;
        if (blockIdx.x == 0 && tid == 0) *(unsigned*)(ws + WS_CTL) = 0u;
        p0_prologue(P, lds, gw, NGW, wave, lane); __syncthreads(); }
    SEAM(0);
    if (IN(1)) { pg8::Gemm g{xb, (const bf16*)(ws + WS_W13A), MTOK, 2 * DFF, DMODEL}; pg8::StaticOrder S; S.init(MTOK, 2 * DFF, G, (int)blockIdx.x);
        pg8::EpiSwiglu E{U, rowss}; pg8::gemm_phase<pg8::EpiSwiglu, pg8::StaticOrder, true, true>(lds, g, S, E); }
    SEAM(1);
    if (IN(2)) { pg8::Gemm g{U, (const bf16*)(ws + WS_W2A), MTOK, DMODEL, DFF}; pg8::StaticOrder S; S.init(MTOK, DMODEL, G, (int)blockIdx.x);
        pg8::EpiResid E{args.in[0], args.out, xb, rowss, 0.5f}; pg8::gemm_phase<pg8::EpiResid, pg8::StaticOrder, true, true>(lds, g, S, E); }
    SEAM(2);
    if (IN(3)) { pg8::Gemm g{xb, (const bf16*)(ws + WS_WIN), MTOK, INW, DMODEL}; pg8::StaticOrder S; S.init(MTOK, INW, G, (int)blockIdx.x);
        pg8::EpiInProj E{ws, args.in[7]}; pg8::gemm_phase<pg8::EpiInProj, pg8::StaticOrder, true, true>(lds, g, S, E); }
    SEAM(3);
    if (IN(4)) {
        constexpr int N_DL = 3 * 2048, N_SB = 2 * 8 * 256; LAS bf16* vt = (LAS bf16*)(lds + wave * 8192);
        for (int it = gw; it < N_DL + N_SB; it += NGW) {
#ifndef NO_DL
            if (it < N_DL) dl_item(it, qdl, kdl, vdl, lse, vt, lane);
#endif
#ifndef NO_SB
            if (it >= N_DL) sb_item(it - N_DL, qsb, ksb, vsb, vt, lane);
#endif
 }
    }
    SEAM(4);
    if (IN(5)) {
        pg8::StaticOrder S; S.init(MTOK, DMODEL, G, (int)blockIdx.x); pg8::Unit u;
        for (int i = 0; S.next(i, u); ++i) combine_rows(u.pm, qdl, lse, ydl, tid);
        asm volatile("s_waitcnt vmcnt(0)" ::: "memory"); __syncthreads();
        { pg8::Gemm g{qsb, (const bf16*)(ws + WS_WSB), MTOK, DMODEL, SBW}; pg8::EpiGate<false> E{mbuf, gates, 0}; pg8::gemm_phase<pg8::EpiGate<false>, pg8::StaticOrder, true, true>(lds, g, S, E); }
        asm volatile("s_waitcnt vmcnt(0)" ::: "memory"); __syncthreads();
        { pg8::Gemm g{ydl, (const bf16*)(ws + WS_WDIL), MTOK, DMODEL, DKVW}; pg8::EpiGate<true> E{mbuf, gates, DMODEL}; pg8::gemm_phase<pg8::EpiGate<true>, pg8::StaticOrder, true, true>(lds, g, S, E); }
    }
    SEAM(5);
    if (IN(6)) { pg8::Gemm g{mbuf, (const bf16*)(ws + WS_WO), MTOK, DMODEL, DMODEL}; pg8::StaticOrder S; S.init(MTOK, DMODEL, G, (int)blockIdx.x);
        pg8::EpiResid E{args.out, args.out, xb, rowss, 1.0f}; pg8::gemm_phase<pg8::EpiResid, pg8::StaticOrder, true, true>(lds, g, S, E); }
    SEAM(6);
    if (IN(7)) { pg8::Gemm g{xb, (const bf16*)(ws + WS_W13B), MTOK, 2 * DFF, DMODEL}; pg8::StaticOrder S; S.init(MTOK, 2 * DFF, G, (int)blockIdx.x);
        pg8::EpiSwiglu E{U, rowss}; pg8::gemm_phase<pg8::EpiSwiglu, pg8::StaticOrder, true, true>(lds, g, S, E); }
    SEAM(7);
    if (IN(8)) { pg8::Gemm g{U, (const bf16*)(ws + WS_W2B), MTOK, DMODEL, DFF}; pg8::StaticOrder S; S.init(MTOK, DMODEL, G, (int)blockIdx.x);
        pg8::EpiResid E{args.out, args.out, nullptr, nullptr, 0.5f}; pg8::gemm_phase<pg8::EpiResid, pg8::StaticOrder, true, true>(lds, g, S, E); }
    SEAM(8);
    if (IN(9)) {
        for (int m = gw; m < MTOK; m += NGW) { f32x4* xr = (f32x4*)(args.out + (size_t)m * DMODEL) + lane; const f32x4* gr = (const f32x4*)args.in[15] + lane; f32x4 v[4]; float s = 0.f;
#pragma unroll
            for (int j = 0; j < 4; ++j) { v[j] = xr[64 * j]; s += (v[j].x * v[j].x + v[j].y * v[j].y) + (v[j].z * v[j].z + v[j].w * v[j].w); }
            const float rstd = 1.0f / sqrtf(wave_sum(s) * (1.0f / DMODEL) + RMS_EPS);
#pragma unroll
            for (int j = 0; j < 4; ++j) xr[64 * j] = v[j] * rstd * gr[64 * j]; }
    }
#undef IN
#undef SEAM
#undef xb
#undef rowss
#undef U
#undef qsb
#undef ksb
#undef vsb
#undef qdl
#undef kdl
#undef vdl
#undef gates
#undef mbuf
#undef ydl
#undef lse
}

#ifndef MK_SINGLE
#define MK_SINGLE 1
#endif
extern "C" void kernel_launch(void* const* d_in, const int* in_sizes, int n_in, void* d_out, int out_size, void* d_ws, size_t ws_size, hipStream_t stream) {
    static int grid = 0;
    if (grid == 0) {
        if (n_in != 16 || in_sizes[0] != MTOK * DMODEL || out_size != MTOK * DMODEL || ws_size < WS_END) { fprintf(stderr, "kernel_launch: unexpected shapes (n_in %d, in0 %d, out %d, ws %zu)\n", n_in, n_in > 0 ? in_sizes[0] : -1, out_size, ws_size); grid = -1; return; }
        int dev = 0, cus = 0, per_cu = 0;
        hipGetDevice(&dev); hipDeviceGetAttribute(&cus, hipDeviceAttributeMultiprocessorCount, dev);
        if (hipFuncSetAttribute((const void*)mk_fwd, hipFuncAttributeMaxDynamicSharedMemorySize, LDS_BYTES) != hipSuccess) { fprintf(stderr, "kernel_launch: hipFuncSetAttribute failed\n"); grid = -1; return; }
        if (hipOccupancyMaxActiveBlocksPerMultiprocessor(&per_cu, (const void*)mk_fwd, NTHREADS, LDS_BYTES) != hipSuccess || per_cu < 1) { fprintf(stderr, "kernel_launch: occupancy query says %d\n", per_cu); per_cu = 1; }
        (void)hipGetLastError();
        grid = cus * 1;
    }
    if (grid < 0) return;
    Args a{};
    for (int i = 0; i < 16; ++i) a.in[i] = (const float*)d_in[i];
    a.out = (float*)d_out; a.ws = (unsigned char*)d_ws;
#if MK_SINGLE
    a.ph_lo = 0; a.ph_hi = NPHASES; a.coop = 1;
    void* kargs[] = {&a};
    hipError_t e = hipLaunchCooperativeKernel((const void*)mk_fwd, dim3(grid), dim3(NTHREADS), kargs, LDS_BYTES, stream);
    if (e != hipSuccess) fprintf(stderr, "kernel_launch: cooperative launch failed: %s (grid %d)\n", hipGetErrorString(e), grid);
#else
    for (int p = 0; p < NPHASES; ++p) { a.ph_lo = p; a.ph_hi = p + 1; a.coop = 0; hipLaunchKernelGGL(mk_fwd, dim3(grid), dim3(NTHREADS), LDS_BYTES, stream, a); }
#endif
}
```

```cpp
#include <hip/hip_runtime.h>
#include <hip/hip_cooperative_groups.h>
#include <cstdio>
#include <cstdint>
namespace cg = cooperative_groups;

constexpr int MTOK = 16384, SEQ = 8192, DMODEL = 1024, DFF = 2816, SBW = 512, DQW = 768, DKVW = 256, INW = 4864;
constexpr float RMS_EPS = 1e-6f;
constexpr float LOG2E = 1.4426950408889634f;
constexpr float QSCALE = 0.125f * 1.4426950408889634f;

constexpr size_t WSO_ROPE = 46u << 20, WSO_RSS = 48u << 20, WSO_QSB = 89u << 20, WSO_KSB = 105u << 20, WSO_VSB = 121u << 20, WSO_QDL = 137u << 20, WSO_KDL = 161u << 20, WSO_VDL = 169u << 20, WSO_GATES = 177u << 20;
#ifndef TS_A
#define TS_A -1
#define TS_B -1
#endif
#define LAS __attribute__((address_space(3)))
#define XB_TMO      128
#define XB_XCNT(j)  (256  + 64 * (j))
#define XB_XSUB(j)  (1280 + 64 * (j))
#define XB_XGEN(j)  (2304 + 64 * (j))
#define XB_TOP      3328
#define XB_TOPGEN   3392
#define XCD_BAR_WORDS 3456
#define XB_SPIN_CAP (1u << 18)

__device__ __forceinline__ unsigned xb_ld(unsigned* p)              { return __hip_atomic_load(p, __ATOMIC_RELAXED, __HIP_MEMORY_SCOPE_AGENT); }
__device__ __forceinline__ unsigned xb_add(unsigned* p, unsigned v) { return __hip_atomic_fetch_add(p, v, __ATOMIC_RELAXED, __HIP_MEMORY_SCOPE_AGENT); }
__device__ __forceinline__ unsigned xb_xcc_id() { return (unsigned)__builtin_amdgcn_s_getreg((3 << 11) | 20) & 0xFu; }
#define XB_SPIN(cond, bar) do { unsigned _sp = 0; while (cond) { __builtin_amdgcn_s_sleep(1); \
    if ((++_sp & 255u) == 0u) { if (xb_ld(&(bar)[XB_TMO])) break; if (_sp > XB_SPIN_CAP) { atomicAdd(&(bar)[XB_TMO], 1u); break; } } } } while (0)

struct XcdBarrier {
    unsigned* bar; unsigned x;
    volatile LAS unsigned* st;
};

__device__ __forceinline__ XcdBarrier xcd_barrier_post(unsigned* bar, volatile LAS unsigned* st) {
    XcdBarrier b; b.bar = bar; b.x = xb_xcc_id(); b.st = st;
    if (threadIdx.x == 0) (void)xb_add(&bar[XB_XCNT(b.x)], 1u);
    return b;
}
__device__ __forceinline__ void xcd_barrier_complete(unsigned* bar, unsigned x, unsigned& nloc, unsigned& nx) {
    const unsigned G = gridDim.x * gridDim.y * gridDim.z;
    unsigned sum, cnt, mine, sp = 0u;
    for (;;) {
        sum = 0u; cnt = 0u; mine = 0u;
#pragma unroll
        for (unsigned j = 0; j < 16; ++j) { const unsigned c = xb_ld(&bar[XB_XCNT(j)]); sum += c; cnt += (c > 0u) ? 1u : 0u; mine = (j == x) ? c : mine; }
        if (sum == G) break;
        __builtin_amdgcn_s_sleep(1);
        if ((++sp & 255u) == 0u) { if (xb_ld(&bar[XB_TMO])) break; if (sp > XB_SPIN_CAP) { atomicAdd(&bar[XB_TMO], 1u); break; } }
    }
    nloc = mine > 0u ? mine : 1u; nx = cnt > 0u ? cnt : 1u;
}

__device__ __forceinline__ void xcd_barrier(const XcdBarrier& b) {
    asm volatile("s_waitcnt vmcnt(0)" ::: "memory");
    __syncthreads();
    if (threadIdx.x == 0) {
        unsigned* bar = b.bar;
        __builtin_amdgcn_s_waitcnt(0);
        unsigned nloc = b.st[0], nx = b.st[1];
        if (nloc == 0u) { xcd_barrier_complete(bar, b.x, nloc, nx); b.st[0] = nloc; b.st[1] = nx; }
        const unsigned old = xb_add(&bar[XB_XSUB(b.x)], 1u);
        const unsigned gen = old / nloc;
        if (old + 1u == (gen + 1u) * nloc) {
            __builtin_amdgcn_fence(__ATOMIC_RELEASE, "agent");
            asm volatile("s_waitcnt vmcnt(0)" ::: "memory");
            const unsigned og = xb_add(&bar[XB_TOP], 1u);
            const unsigned tg = og / nx;
            if (og + 1u == (tg + 1u) * nx) xb_add(&bar[XB_TOPGEN], 1u);
            else XB_SPIN(xb_ld(&bar[XB_TOPGEN]) == tg, bar);
            __builtin_amdgcn_fence(__ATOMIC_ACQUIRE, "agent");
            xb_add(&bar[XB_XGEN(b.x)], 1u);
            asm volatile("s_waitcnt vmcnt(0)" ::: "memory");
        } else {
            XB_SPIN(xb_ld(&bar[XB_XGEN(b.x)]) == gen, bar);
            __builtin_amdgcn_fence(__ATOMIC_ACQUIRE, "agent");
            asm volatile("s_waitcnt vmcnt(0)" ::: "memory");
        }
    }
    __syncthreads();
}

namespace pg8 {
#define PG8_LAS __attribute__((address_space(3)))
typedef unsigned short bf16_t;
typedef short bf16x8 __attribute__((ext_vector_type(8)));
typedef float f32x4 __attribute__((ext_vector_type(4)));
typedef unsigned u32x4 __attribute__((ext_vector_type(4)));
constexpr int BM = 256, BK = 64, HALF = 128, HTB = HALF * BK * 2  , STAGE_BYTES = 8 * HTB, NXCD = 8, WGM = 8;

__host__ __device__ __forceinline__ int lds_byte(int r, int c) { const int st = (r >> 4) * 2 + (c >> 5), rr = r & 15, cc = c & 31, ob = rr * 64 + cc * 2; return st * 1024 + (ob ^ (((ob >> 9) & 1) << 5)); }
__host__ __device__ __forceinline__ void stage_rc(int b, int& R, int& C) { const int st = b / 1024, sb = b % 1024, swz = sb ^ (((sb >> 9) & 1) << 5); R = (st >> 1) * 16 + swz / 64; C = (st & 1) * 32 + (swz % 64) / 2; }
__host__ __device__ __forceinline__ int perm32(int rho) { const int n = rho >> 4, i = rho & 15; return 8 * (i >> 2) + 4 * n + (i & 3); }

struct Unit { int pm, pn; };
struct Gemm { const bf16_t* A; const bf16_t* Bt; int M, N, K; };

struct StaticOrder {
    int nM, nN, nwg, G, c;
    __host__ __device__ void init(int M, int N, int G_, int c_) { nM = M / BM; nN = N / BM; nwg = nM * nN; G = G_; c = c_; }
    __host__ __device__ bool next(int i, Unit& u) const {
        const long L = (long)i * G + c; if (L >= nwg) return false;
        if (G == 256 && nM == 64 && (nwg & 7) == 0) { u.pm = 8 * (c & 7) + ((c >> 3) & 7); u.pn = 4 * i + (c >> 6); return true; }
        int wgid = (int)L; { const int q = nwg / NXCD, r = nwg % NXCD, xcd = wgid % NXCD, off = wgid / NXCD; wgid = (xcd < r ? xcd * (q + 1) : r * (q + 1) + (xcd - r) * q) + off; }
        const int nig = WGM * nN, gid = wgid / nig, fm = gid * WGM, gsz = (nM - fm) < WGM ? (nM - fm) : WGM;
        u.pm = fm + ((wgid % nig) % gsz); u.pn = (wgid % nig) / gsz; return true;
    }
    __device__ __forceinline__ void a_ready(const Unit&) const {}
    __device__ __forceinline__ void done(const Unit&) const {}
};

typedef float f32x2_cv __attribute__((ext_vector_type(2))); typedef __bf16 bf16x2_cv __attribute__((ext_vector_type(2)));
__device__ __forceinline__ unsigned cvt_pk_bf16(float lo, float hi) { const f32x2_cv v = {lo, hi}; const bf16x2_cv b = __builtin_convertvector(v, bf16x2_cv); return __builtin_bit_cast(unsigned, b); }
typedef float f32x2 __attribute__((ext_vector_type(2)));
__device__ __forceinline__ u32x4 pack8(const f32x4 a, const f32x4 b) { u32x4 w; w.x = cvt_pk_bf16(a[0], a[1]); w.y = cvt_pk_bf16(a[2], a[3]); w.z = cvt_pk_bf16(b[0], b[1]); w.w = cvt_pk_bf16(b[2], b[3]); return w; }
__device__ __forceinline__ float bf_lo(unsigned w) { return __builtin_bit_cast(float, w << 16); }
__device__ __forceinline__ float bf_hi(unsigned w) { return __builtin_bit_cast(float, w & 0xffff0000u); }
__device__ __forceinline__ void load_rstd(float (&rs)[2][4], const float* rowss, int pm, int wr, int fr, int fq) {
#pragma unroll
    for (int ai = 0; ai < 2; ++ai)
#pragma unroll
        for (int m = 0; m < 4; ++m) { const int row = pm * BM + ai * HALF + wr * 64 + m * 16 + fr;
            const f32x4 p = *(const f32x4*)(rowss + (size_t)row * 16 + fq * 4); float s = (p[0] + p[1]) + (p[2] + p[3]);
            s += __shfl_xor(s, 16); s += __shfl_xor(s, 32); rs[ai][m] = __builtin_amdgcn_rsqf(s * (1.0f / DMODEL) + RMS_EPS); }
}
constexpr int RSTAB_OFF = 147456 - 4096 + 2048;
__device__ __forceinline__ void get_rstd(float (&rs)[2][4], const float* rowss, PG8_LAS const float* tab, int tab_pm, int pm, int wr, int fr, int fq) {
    if (pm == tab_pm) {
#pragma unroll
        for (int ai = 0; ai < 2; ++ai)
#pragma unroll
            for (int m = 0; m < 4; ++m) rs[ai][m] = tab[ai * HALF + wr * 64 + m * 16 + fr];
    } else load_rstd(rs, rowss, pm, wr, fr, fq);
}
__device__ __forceinline__ void rstd_table(PG8_LAS float* tab, const float* rowss, int pm) {
    const int t = threadIdx.x;
    if (t < BM) { const float* p = rowss + (size_t)(pm * BM + t) * 16; const f32x4 a = *(const f32x4*)p, b = *(const f32x4*)(p + 4), c = *(const f32x4*)(p + 8), d = *(const f32x4*)(p + 12);
        const float s = ((a[0] + a[1]) + (a[2] + a[3])) + ((b[0] + b[1]) + (b[2] + b[3])) + ((c[0] + c[1]) + (c[2] + c[3])) + ((d[0] + d[1]) + (d[2] + d[3]));
        tab[t] = __builtin_amdgcn_rsqf(s * (1.0f / DMODEL) + RMS_EPS); }
    __syncthreads();
}
struct EpiSwiglu {
    static constexpr bool PERM = true, AFTER_DRAIN = false;
    bf16_t* U; const float* rowss; PG8_LAS const float* tab; int tab_pm;
    __device__ __forceinline__ void operator()(const f32x4 (&acc)[2][2][4][2], const Unit& u, int wr, int wc, int fr, int fq) const {
        float rs[2][4]; get_rstd(rs, rowss, tab, tab_pm, u.pm, wr, fr, fq);
        const int col0 = u.pn * 128 + wc * 32 + 8 * fq;
#pragma unroll
        for (int ai = 0; ai < 2; ++ai)
#pragma unroll
            for (int m = 0; m < 4; ++m) { const int row = u.pm * BM + ai * HALF + wr * 64 + m * 16 + fr; const float r = rs[ai][m], rn = -LOG2E * r, r2 = r * r; f32x4 o[2];
#pragma unroll
                for (int n = 0; n < 2; ++n) { const f32x4 t = acc[ai][0][m][n] * rn, p = acc[ai][0][m][n] * acc[ai][1][m][n];
#pragma unroll
                    for (int e = 0; e < 4; ++e) { const float sg = __builtin_amdgcn_rcpf(1.0f + __builtin_amdgcn_exp2f(t[e])); o[n][e] = p[e] * (r2 * sg); } }
                *(u32x4*)(U + (size_t)row * DFF + col0) = pack8(o[0], o[1]); }
    }
};
template <bool RES_BF16, bool OUT_F32> struct EpiResid {
    static constexpr bool PERM = true, AFTER_DRAIN = false;
    const void* res; void* out; float* rowss; float scale;
    __device__ __forceinline__ void operator()(const f32x4 (&acc)[2][2][4][2], const Unit& u, int wr, int wc, int fr, int fq) const {
        const size_t off0 = (size_t)(u.pm * BM + wr * 64 + fr) * DMODEL + u.pn * BM + wc * 32 + 8 * fq;
        u32x4 rb[2][4][2];
        if (RES_BF16) {
#pragma unroll
            for (int ai = 0; ai < 2; ++ai)
#pragma unroll
                for (int m = 0; m < 4; ++m)
#pragma unroll
                    for (int bj = 0; bj < 2; ++bj) rb[ai][m][bj] = __builtin_nontemporal_load((const u32x4*)((const bf16_t*)res + off0 + (size_t)(ai * HALF + m * 16) * DMODEL + bj * HALF));
        }
#pragma unroll
        for (int ai = 0; ai < 2; ++ai) {
            f32x4 rf[4][2][2];
            if (!RES_BF16) {
#pragma unroll
                for (int m = 0; m < 4; ++m)
#pragma unroll
                    for (int bj = 0; bj < 2; ++bj) { const float* p = (const float*)res + off0 + (size_t)(ai * HALF + m * 16) * DMODEL + bj * HALF; rf[m][bj][0] = *(const f32x4*)p; rf[m][bj][1] = *(const f32x4*)(p + 4); }
            }
#pragma unroll
            for (int m = 0; m < 4; ++m) { const int row = u.pm * BM + ai * HALF + wr * 64 + m * 16 + fr; float ss = 0.f;
#pragma unroll
                for (int bj = 0; bj < 2; ++bj) { const size_t off = off0 + (size_t)(ai * HALF + m * 16) * DMODEL + bj * HALF;
                    f32x4 r0, r1;
                    if (RES_BF16) { const u32x4 t = rb[ai][m][bj]; r0 = (f32x4){bf_lo(t.x), bf_hi(t.x), bf_lo(t.y), bf_hi(t.y)}; r1 = (f32x4){bf_lo(t.z), bf_hi(t.z), bf_lo(t.w), bf_hi(t.w)}; }
                    else { r0 = rf[m][bj][0]; r1 = rf[m][bj][1]; }
                    const f32x4 o0 = r0 + acc[ai][bj][m][0] * scale, o1 = r1 + acc[ai][bj][m][1] * scale;
                    if (OUT_F32) { *(f32x4*)((float*)out + off) = o0; *(f32x4*)((float*)out + off + 4) = o1; }
                    else *(u32x4*)((bf16_t*)out + off) = pack8(o0, o1);
                    ss += (o0[0] * o0[0] + o0[1] * o0[1]) + (o0[2] * o0[2] + o0[3] * o0[3]) + (o1[0] * o1[0] + o1[1] * o1[1]) + (o1[2] * o1[2] + o1[3] * o1[3]); }
                if (rowss) { ss += __shfl_xor(ss, 16); ss += __shfl_xor(ss, 32); if (fq == 0) rowss[(size_t)row * 16 + u.pn * 4 + wc] = ss; } }
        }
    }
};
struct EpiResidNorm {
    static constexpr bool PERM = true, AFTER_DRAIN = true;
    const bf16_t* res; float* out; float* rowss; const float* gfin; float scale; XcdBarrier xbar;
    __device__ __forceinline__ void fused(f32x4 (&acc)[2][2][4][2], const Unit& u, int wr, int wc, int fr, int fq, PG8_LAS unsigned char* lds, int wid, int lane) const {
        const size_t off0 = (size_t)(u.pm * BM + wr * 64 + fr) * DMODEL + u.pn * BM + wc * 32 + 8 * fq;
        u32x4 rb[2][4][2];
#pragma unroll
        for (int ai = 0; ai < 2; ++ai)
#pragma unroll
            for (int m = 0; m < 4; ++m)
#pragma unroll
                for (int bj = 0; bj < 2; ++bj) rb[ai][m][bj] = __builtin_nontemporal_load((const u32x4*)(res + off0 + (size_t)(ai * HALF + m * 16) * DMODEL + bj * HALF));
#pragma unroll
        for (int ai = 0; ai < 2; ++ai)
#pragma unroll
            for (int m = 0; m < 4; ++m) { const int row = u.pm * BM + ai * HALF + wr * 64 + m * 16 + fr; float ss = 0.f;
#pragma unroll
                for (int bj = 0; bj < 2; ++bj) { const u32x4 t = rb[ai][m][bj];
                    const f32x4 o0 = (f32x4){bf_lo(t.x), bf_hi(t.x), bf_lo(t.y), bf_hi(t.y)} + acc[ai][bj][m][0] * scale, o1 = (f32x4){bf_lo(t.z), bf_hi(t.z), bf_lo(t.w), bf_hi(t.w)} + acc[ai][bj][m][1] * scale;
                    acc[ai][bj][m][0] = o0; acc[ai][bj][m][1] = o1;
                    ss += (o0[0] * o0[0] + o0[1] * o0[1]) + (o0[2] * o0[2] + o0[3] * o0[3]) + (o1[0] * o1[0] + o1[1] * o1[1]) + (o1[2] * o1[2] + o1[3] * o1[3]); }
                ss += __shfl_xor(ss, 16); ss += __shfl_xor(ss, 32); if (fq == 0) rowss[(size_t)row * 16 + u.pn * 4 + wc] = ss; }
        xcd_barrier(xbar);
        if (TS_A >= 0 && blockIdx.x == 0) { if (threadIdx.x == 0) ((PG8_LAS unsigned long long*)(lds + 147456 - 4096 + 1024))[9] = __builtin_amdgcn_s_memrealtime(); __syncthreads(); }
        float rs[2][4]; load_rstd(rs, rowss, u.pm, wr, fr, fq);
        f32x4 gv[2][2];
#pragma unroll
        for (int bj = 0; bj < 2; ++bj)
#pragma unroll
            for (int n = 0; n < 2; ++n) gv[bj][n] = *(const f32x4*)(gfin + u.pn * BM + bj * HALF + wc * 32 + 8 * fq + 4 * n);
#pragma unroll
        for (int ai = 0; ai < 2; ++ai)
#pragma unroll
            for (int m = 0; m < 4; ++m)
#pragma unroll
                for (int bj = 0; bj < 2; ++bj) { float* p = out + off0 + (size_t)(ai * HALF + m * 16) * DMODEL + bj * HALF; const float r = rs[ai][m];
                    f32x4 q0 = acc[ai][bj][m][0] * r * gv[bj][0], q1 = acc[ai][bj][m][1] * r * gv[bj][1];
                    if (TS_A >= 0 && blockIdx.x == 0) {
                        const PG8_LAS unsigned long long* ts = (const PG8_LAS unsigned long long*)(lds + 147456 - 4096 + 1024);
                        const unsigned nper = (unsigned)((ts[TS_B < 0 ? 0 : TS_B] - ts[TS_A < 0 ? 0 : TS_A]) * 64ull / 100ull); const unsigned base = (unsigned)((((ai * 4 + m) * 2 + bj) * 8) * 512 + threadIdx.x);
#pragma unroll
                        for (int c = 0; c < 4; ++c) { if (base + c * 512 < nper) q0[c] += 0.05f; if (base + (4 + c) * 512 < nper) q1[c] += 0.05f; } }
                    *(f32x4*)p = q0; *(f32x4*)(p + 4) = q1; }
    }
};
struct EpiInProj {
    static constexpr bool PERM = true, AFTER_DRAIN = false;
    unsigned char* ws; const float* bgate; PG8_LAS const float* tab; int tab_pm;
    __device__ __forceinline__ void operator()(const f32x4 (&acc)[2][2][4][2], const Unit& u, int wr, int wc, int fr, int fq) const {
        float rs[2][4]; get_rstd(rs, (const float*)(ws + WSO_RSS), tab, tab_pm, u.pm, wr, fr, fq);
        const int pn = u.pn;
        bf16_t *qsb = (bf16_t*)(ws + WSO_QSB), *ksb = (bf16_t*)(ws + WSO_KSB), *vsb = (bf16_t*)(ws + WSO_VSB), *qdl = (bf16_t*)(ws + WSO_QDL), *kdl = (bf16_t*)(ws + WSO_KDL), *vdl = (bf16_t*)(ws + WSO_VDL), *gates = (bf16_t*)(ws + WSO_GATES);
        const float* ropec = (const float*)(ws + WSO_ROPE); const float* ropes = ropec + SEQ * 32;
        if (pn < 6 || pn == 10) {
            bf16_t* base; int pitch, c0; float sc = 1.f;
            if (pn < 2) { base = qsb; pitch = SBW; c0 = pn * 256; sc = QSCALE; } else if (pn < 4) { base = ksb; pitch = SBW; c0 = (pn - 2) * 256; }
            else if (pn < 6) { base = vsb; pitch = SBW; c0 = (pn - 4) * 256; } else { base = vdl; pitch = DKVW; c0 = 0; }
#pragma unroll
            for (int ai = 0; ai < 2; ++ai)
#pragma unroll
                for (int m = 0; m < 4; ++m) { const int row = u.pm * BM + ai * HALF + wr * 64 + m * 16 + fr; const float r = rs[ai][m] * sc;
#pragma unroll
                    for (int bj = 0; bj < 2; ++bj) *(u32x4*)(base + (size_t)row * pitch + c0 + bj * HALF + wc * 32 + 8 * fq) = pack8(acc[ai][bj][m][0] * r, acc[ai][bj][m][1] * r); }
        } else if (pn < 10) {
            bf16_t* base; int pitch, c0; float sc = 1.f;
            if (pn < 9) { base = qdl; pitch = DQW; c0 = (pn - 6) * 256; sc = QSCALE; } else { base = kdl; pitch = DKVW; c0 = 0; }
#pragma unroll
            for (int am = 0; am < 4; ++am) { const int ai = am >> 1, m0 = (am & 1) * 2;
                f32x4 cs[2][2], sn[2][2];
#pragma unroll
                for (int mm = 0; mm < 2; ++mm) { const int pos = (u.pm * BM + ai * HALF + wr * 64 + (m0 + mm) * 16 + fr) & (SEQ - 1);
#pragma unroll
                    for (int n = 0; n < 2; ++n) { cs[mm][n] = *(const f32x4*)(ropec + pos * 32 + 8 * fq + 4 * n); sn[mm][n] = *(const f32x4*)(ropes + pos * 32 + 8 * fq + 4 * n); } }
#pragma unroll
                for (int mm = 0; mm < 2; ++mm) { const int m = m0 + mm, row = u.pm * BM + ai * HALF + wr * 64 + m * 16 + fr; const float r = rs[ai][m] * sc;
                    f32x4 o1[2], o2[2];
#pragma unroll
                    for (int n = 0; n < 2; ++n) { const f32x4 t1 = acc[ai][0][m][n] * r, t2 = acc[ai][1][m][n] * r; o1[n] = t1 * cs[mm][n] - t2 * sn[mm][n]; o2[n] = t2 * cs[mm][n] + t1 * sn[mm][n]; }
                    bf16_t* rp = base + (size_t)row * pitch + c0 + wc * 64 + 8 * fq;
                    *(u32x4*)(rp) = pack8(o1[0], o1[1]); *(u32x4*)(rp + 32) = pack8(o2[0], o2[1]); }
                asm volatile("" ::: "memory");
            }
        } else {
            const int c0 = (pn - 11) * 256;
            f32x4 bv[2][2];
#pragma unroll
            for (int bj = 0; bj < 2; ++bj)
#pragma unroll
                for (int n = 0; n < 2; ++n) bv[bj][n] = *(const f32x4*)(bgate + c0 + bj * HALF + wc * 32 + 8 * fq + 4 * n) * (-LOG2E);
#pragma unroll
            for (int ai = 0; ai < 2; ++ai)
#pragma unroll
                for (int m = 0; m < 4; ++m) { const int row = u.pm * BM + ai * HALF + wr * 64 + m * 16 + fr; const float rn = -LOG2E * rs[ai][m];
#pragma unroll
                    for (int bj = 0; bj < 2; ++bj) { const int col = c0 + bj * HALF + wc * 32 + 8 * fq; f32x4 o[2];
#pragma unroll
                        for (int n = 0; n < 2; ++n) { const f32x4 v = acc[ai][bj][m][n] * rn + bv[bj][n];
#pragma unroll
                            for (int e = 0; e < 4; ++e) o[n][e] = __builtin_amdgcn_rcpf(1.0f + __builtin_amdgcn_exp2f(v[e])); }
                        *(u32x4*)(gates + (size_t)row * 2048 + col) = pack8(o[0], o[1]); } }
        }
    }
};
template <bool SECOND> struct EpiGate {
    static constexpr bool PERM = true, AFTER_DRAIN = false;
    bf16_t* mbuf; const bf16_t* gates; int goff;
    __device__ __forceinline__ void operator()(const f32x4 (&acc)[2][2][4][2], const Unit& u, int wr, int wc, int fr, int fq) const {
        const int row0 = u.pm * BM + wr * 64 + fr, col0 = u.pn * BM + wc * 32 + 8 * fq;
        u32x4 gq[2][4][2];
        if (!SECOND) {
#pragma unroll
            for (int ai = 0; ai < 2; ++ai)
#pragma unroll
                for (int m = 0; m < 4; ++m)
#pragma unroll
                    for (int bj = 0; bj < 2; ++bj) gq[ai][m][bj] = __builtin_nontemporal_load((const u32x4*)(gates + (size_t)(row0 + ai * HALF + m * 16) * 2048 + goff + col0 + bj * HALF));
        }
#pragma unroll
        for (int ai = 0; ai < 2; ++ai) {
            u32x4 tq[4][2];
            if (SECOND) {
#pragma unroll
                for (int m = 0; m < 4; ++m)
#pragma unroll
                    for (int bj = 0; bj < 2; ++bj) { gq[ai][m][bj] = __builtin_nontemporal_load((const u32x4*)(gates + (size_t)(row0 + ai * HALF + m * 16) * 2048 + goff + col0 + bj * HALF)); tq[m][bj] = *(const u32x4*)(mbuf + (size_t)(row0 + ai * HALF + m * 16) * DMODEL + col0 + bj * HALF); }
            }
#pragma unroll
            for (int m = 0; m < 4; ++m)
#pragma unroll
                for (int bj = 0; bj < 2; ++bj) { const int row = row0 + ai * HALF + m * 16, col = col0 + bj * HALF; const u32x4 g = gq[ai][m][bj];
                    f32x4 o0 = acc[ai][bj][m][0] * (f32x4){bf_lo(g.x), bf_hi(g.x), bf_lo(g.y), bf_hi(g.y)}, o1 = acc[ai][bj][m][1] * (f32x4){bf_lo(g.z), bf_hi(g.z), bf_lo(g.w), bf_hi(g.w)};
                    if (SECOND) { const u32x4 t = tq[m][bj]; o0 += (f32x4){bf_lo(t.x), bf_hi(t.x), bf_lo(t.y), bf_hi(t.y)}; o1 += (f32x4){bf_lo(t.z), bf_hi(t.z), bf_lo(t.w), bf_hi(t.w)}; }
                    *(u32x4*)(mbuf + (size_t)row * DMODEL + col) = pack8(o0, o1); }
        }
    }
};

template <class Epi, class Sched, bool ALIGN_EPI = false, bool SP2 = false>
__device__ __forceinline__ void gemm_phase(PG8_LAS unsigned char* lds, const Gemm g, const Sched& S, const Epi& E) {
    const int tid = threadIdx.x, wid = __builtin_amdgcn_readfirstlane(tid >> 6), lane = tid & 63, wr = wid >> 2, wc = wid & 3, fr = lane & 15, fq = lane >> 4;
    const int K = g.K, nt = K / BK;
    unsigned voffA[2], voffB[2];
#pragma unroll
    for (int i = 0; i < 2; ++i) { int R, C; stage_rc(tid * 16 + i * 8192, R, C); const int Rb = Epi::PERM ? ((R & ~31) + perm32(R & 31)) : R;
        voffA[i] = (unsigned)(R * K + C) * 2u; voffB[i] = (unsigned)(Rb * K + C) * 2u; }
    const size_t kstep = (size_t)(BK * 2);
    const size_t hstep = (size_t)HALF * K * 2;
    const size_t tstep = 2 * hstep;
    const unsigned ldsw = (unsigned)wid * 1024u;
    const int aoff = lds_byte(wr * 64 + fr, fq * 8), boff = lds_byte(wc * 32 + fr, fq * 8);
#define PG8_SA(b, h) (((b) * 2 + (h)) * HTB)
#define PG8_SB(b, h) ((4 + (b) * 2 + (h)) * HTB)
#define PG8_STAGE(bufoff, gbase, voff) do { _Pragma("unroll") for (int _i = 0; _i < 2; ++_i) \
        __builtin_amdgcn_global_load_lds((const unsigned*)((const char*)(gbase) + (voff)[_i]), (PG8_LAS unsigned*)(lds + (bufoff) + ldsw + _i * 8192), 16, 0, 0); } while (0)
#define PG8_LDA(dst, b, h) do { _Pragma("unroll") for (int m = 0; m < 4; ++m) _Pragma("unroll") for (int k = 0; k < 2; ++k) dst[m][k] = *(const PG8_LAS bf16x8*)(lds + PG8_SA(b, h) + aoff + m * 2048 + k * 1024); } while (0)
#define PG8_LDB(dst, b, h) do { _Pragma("unroll") for (int n = 0; n < 2; ++n) _Pragma("unroll") for (int k = 0; k < 2; ++k) dst[n][k] = *(const PG8_LAS bf16x8*)(lds + PG8_SB(b, h) + boff + n * 2048 + k * 1024); } while (0)
#define PG8_MMA(ai, bj, At, Bt) do { __builtin_amdgcn_s_setprio(1); _Pragma("unroll") for (int m = 0; m < 4; ++m) _Pragma("unroll") for (int n = 0; n < 2; ++n) _Pragma("unroll") for (int k = 0; k < 2; ++k) \
        acc[ai][bj][m][n] = __builtin_amdgcn_mfma_f32_16x16x32_bf16(Bt[n][k], At[m][k], acc[ai][bj][m][n], 0, 0, 0); __builtin_amdgcn_s_setprio(0); } while (0)
#define PG8_WAIT_V(n) asm volatile("s_waitcnt vmcnt(" #n ")" ::: "memory")
#define PG8_WAIT_L(n) asm volatile("s_waitcnt lgkmcnt(" #n ")" ::: "memory")
#define PG8_BAR __builtin_amdgcn_s_barrier()
#define PG8_SCHED __builtin_amdgcn_sched_barrier(0)
    Unit cur, nxt; int ui = 0;
    if (!S.next(0, cur)) return;
    f32x4 acc[2][2][4][2];
#pragma unroll
    for (int a = 0; a < 2; ++a)
#pragma unroll
        for (int b = 0; b < 2; ++b)
#pragma unroll
            for (int m = 0; m < 4; ++m)
#pragma unroll
                for (int n = 0; n < 2; ++n) acc[a][b][m][n] = (f32x4){0.f, 0.f, 0.f, 0.f};
    bf16x8 At[4][2], B0[2][2], B1[2][2];
    const char* cA = (const char*)g.A + (size_t)cur.pm * tstep; const char* cB = (const char*)g.Bt + (size_t)cur.pn * tstep;
    S.a_ready(cur);
    if constexpr (SP2) {
        PG8_STAGE(PG8_SB(0, 0), cB, voffB); PG8_STAGE(PG8_SB(0, 1), cB + hstep, voffB); PG8_STAGE(PG8_SA(0, 0), cA, voffA); PG8_STAGE(PG8_SA(0, 1), cA + hstep, voffA);
        if (wr == 1) PG8_BAR;
        PG8_WAIT_V(2); PG8_BAR;
        PG8_STAGE(PG8_SB(1, 0), cB + kstep, voffB); PG8_STAGE(PG8_SA(1, 0), cA + kstep, voffA); PG8_STAGE(PG8_SB(1, 1), cB + hstep + kstep, voffB);
        PG8_WAIT_V(6); PG8_BAR;
    } else {
        PG8_STAGE(PG8_SB(0, 0), cB, voffB); PG8_STAGE(PG8_SA(0, 0), cA, voffA); PG8_STAGE(PG8_SB(0, 1), cB + hstep, voffB); PG8_STAGE(PG8_SA(0, 1), cA + hstep, voffA);
        if (wr == 1) PG8_BAR;
        PG8_WAIT_V(4); PG8_BAR;
        PG8_STAGE(PG8_SB(1, 0), cB + kstep, voffB); PG8_STAGE(PG8_SA(1, 0), cA + kstep, voffA); PG8_STAGE(PG8_SB(1, 1), cB + hstep + kstep, voffB);
        PG8_WAIT_V(6); PG8_BAR;
    }
    for (;;) {
        const bool has_next = S.next(ui + 1, nxt);
        const char* nA = has_next ? (const char*)g.A + (size_t)nxt.pm * tstep : cA; const char* nB = has_next ? (const char*)g.Bt + (size_t)nxt.pn * tstep : cB;
        for (int t = 0; t < nt; t += 2) {
            const bool last = (t == nt - 2);
            const char* a1 = cA + (size_t)(t + 1) * kstep;
            const char* a2 = last ? nA : cA + (size_t)(t + 2) * kstep; const char* b2 = last ? nB : cB + (size_t)(t + 2) * kstep;
            const char* a3 = a2 + kstep; const char* b3 = b2 + kstep;
            if (last && has_next) S.a_ready(nxt);
            if constexpr (SP2) {
            PG8_LDB(B0, 0, 0); PG8_LDB(B1, 0, 1); PG8_SCHED; PG8_LDA(At, 0, 0); PG8_STAGE(PG8_SA(1, 1), a1 + hstep, voffA);
            PG8_WAIT_V(8); PG8_WAIT_L(0); PG8_BAR; PG8_MMA(0, 0, At, B0); PG8_MMA(0, 1, At, B1); PG8_BAR; PG8_SCHED;
            PG8_LDA(At, 0, 1); PG8_STAGE(PG8_SB(0, 0), b2, voffB); PG8_STAGE(PG8_SB(0, 1), b2 + hstep, voffB); PG8_STAGE(PG8_SA(0, 0), a2, voffA);
            PG8_WAIT_V(8); PG8_WAIT_L(0); PG8_BAR; PG8_MMA(1, 0, At, B0); PG8_MMA(1, 1, At, B1); PG8_BAR; PG8_SCHED;
            PG8_LDB(B0, 1, 0); PG8_LDB(B1, 1, 1); PG8_SCHED; PG8_LDA(At, 1, 0); PG8_STAGE(PG8_SA(0, 1), a2 + hstep, voffA);
            PG8_WAIT_V(8); PG8_WAIT_L(0); PG8_BAR; PG8_MMA(0, 0, At, B0); PG8_MMA(0, 1, At, B1); PG8_BAR; PG8_SCHED;
            PG8_LDA(At, 1, 1); PG8_STAGE(PG8_SB(1, 0), b3, voffB); PG8_STAGE(PG8_SB(1, 1), b3 + hstep, voffB); PG8_STAGE(PG8_SA(1, 0), a3, voffA);
            PG8_WAIT_V(8); PG8_WAIT_L(0); PG8_BAR; PG8_MMA(1, 0, At, B0); PG8_MMA(1, 1, At, B1); PG8_BAR; PG8_SCHED;
            } else {
            PG8_LDB(B0, 0, 0); PG8_SCHED; PG8_LDA(At, 0, 0); PG8_STAGE(PG8_SA(1, 1), a1 + hstep, voffA);
            PG8_WAIT_L(8); PG8_BAR; PG8_WAIT_L(0); PG8_MMA(0, 0, At, B0); PG8_BAR; PG8_SCHED;
            PG8_LDB(B1, 0, 1); PG8_STAGE(PG8_SB(0, 0), b2, voffB);
            PG8_BAR; PG8_WAIT_L(0); PG8_MMA(0, 1, At, B1); PG8_BAR;
            PG8_LDA(At, 0, 1); PG8_STAGE(PG8_SA(0, 0), a2, voffA);
            PG8_BAR; PG8_WAIT_L(0); PG8_MMA(1, 0, At, B0); PG8_BAR; PG8_SCHED;
            PG8_STAGE(PG8_SB(0, 1), b2 + hstep, voffB);
            PG8_WAIT_V(6); PG8_BAR; PG8_MMA(1, 1, At, B1); PG8_BAR;
            PG8_LDB(B0, 1, 0); PG8_SCHED; PG8_LDA(At, 1, 0); PG8_STAGE(PG8_SA(0, 1), a2 + hstep, voffA);
            PG8_WAIT_L(8); PG8_BAR; PG8_WAIT_L(0); PG8_MMA(0, 0, At, B0); PG8_BAR; PG8_SCHED;
            PG8_LDB(B1, 1, 1); PG8_STAGE(PG8_SB(1, 0), b3, voffB);
            PG8_BAR; PG8_WAIT_L(0); PG8_MMA(0, 1, At, B1); PG8_BAR;
            PG8_LDA(At, 1, 1); PG8_STAGE(PG8_SA(1, 0), a3, voffA);
            PG8_BAR; PG8_WAIT_L(0); PG8_MMA(1, 0, At, B0); PG8_BAR; PG8_SCHED;
            PG8_STAGE(PG8_SB(1, 1), b3 + hstep, voffB);
            PG8_WAIT_V(6); PG8_BAR; PG8_MMA(1, 1, At, B1); PG8_BAR;
            }
        }
        if constexpr (ALIGN_EPI) { if (wr == 0) PG8_BAR; }
        if constexpr (!Epi::AFTER_DRAIN) { E(acc, cur, wr, wc, fr, fq); S.done(cur); }
        if (!has_next) break;
#pragma unroll
        for (int a = 0; a < 2; ++a)
#pragma unroll
            for (int b = 0; b < 2; ++b)
#pragma unroll
                for (int m = 0; m < 4; ++m)
#pragma unroll
                    for (int n = 0; n < 2; ++n) acc[a][b][m][n] = (f32x4){0.f, 0.f, 0.f, 0.f};
        cur = nxt; cA = nA; cB = nB; ++ui;
        if constexpr (ALIGN_EPI) { if (wr == 1) PG8_BAR; }
    }
    PG8_WAIT_V(0);
    if constexpr (!ALIGN_EPI) { if (wr == 0) PG8_BAR; }
    PG8_BAR;
    if constexpr (Epi::AFTER_DRAIN) { E.fused(acc, cur, wr, wc, fr, fq, lds, wid, lane); S.done(cur); }
#undef PG8_SA
#undef PG8_SB
#undef PG8_STAGE
#undef PG8_LDA
#undef PG8_LDB
#undef PG8_MMA
#undef PG8_WAIT_V
#undef PG8_WAIT_L
#undef PG8_BAR
#undef PG8_SCHED
}
}
typedef unsigned short bf16;
typedef unsigned v4u __attribute__((ext_vector_type(4)));
typedef float f32x4 __attribute__((ext_vector_type(4)));
typedef short s16x8 __attribute__((ext_vector_type(8)));
typedef float f32x16 __attribute__((ext_vector_type(16)));
#define LDS_WAIT() asm volatile("s_waitcnt lgkmcnt(0)" ::: "memory")
constexpr int NWAVES = 8, NTHREADS = 512;
constexpr int RING_BYTES = 131072, LDS_BYTES = 147456, LDSCTL_OFF = LDS_BYTES - 4096;
constexpr size_t MiB = 1u << 20, HMiB = 1u << 19;
constexpr size_t WS_W13A = 0, WS_W2A = 11 * MiB, WS_WIN = 33 * HMiB, WS_WSB = 26 * MiB, WS_WDIL = 27 * MiB, WS_WO = 55 * HMiB, WS_W13B = 59 * HMiB, WS_W2B = 81 * HMiB;
constexpr size_t WS_ROPE = 46 * MiB, WS_RSS = 48 * MiB, WS_YDL = 49 * MiB, WS_XB = 57 * MiB;
constexpr size_t WS_U = 89 * MiB;
constexpr size_t WS_QSB = 89 * MiB, WS_KSB = 105 * MiB, WS_VSB = 121 * MiB, WS_QDL = 137 * MiB, WS_KDL = 161 * MiB, WS_VDL = 169 * MiB, WS_GATES = 177 * MiB;
constexpr size_t WS_MBUF = WS_KSB;
constexpr size_t WS_LSE = 241 * MiB, WS_CTL = 242 * MiB, WS_END = 243 * MiB;
static_assert(WS_ROPE == WSO_ROPE && WS_RSS == WSO_RSS && WS_QSB == WSO_QSB && WS_KSB == WSO_KSB && WS_VSB == WSO_VSB && WS_QDL == WSO_QDL && WS_KDL == WSO_KDL && WS_VDL == WSO_VDL && WS_GATES == WSO_GATES, "d_ws map");
static_assert(WS_W13A + (size_t)2 * DFF * DMODEL * 2 == WS_W2A && WS_W2A + (size_t)DMODEL * DFF * 2 == WS_WIN && WS_WIN + (size_t)INW * DMODEL * 2 == WS_WSB && WS_WO + (size_t)DMODEL * DMODEL * 2 == WS_W13B
              && WS_W13B + (size_t)2 * DFF * DMODEL * 2 == WS_W2B && WS_W2B + (size_t)DMODEL * DFF * 2 == WS_ROPE && WS_U + (size_t)MTOK * DFF * 2 == WS_GATES && WS_GATES + (size_t)MTOK * 2048 * 2 == WS_LSE, "d_ws map");

__device__ __forceinline__ unsigned f2bf(float f) { unsigned u = __builtin_bit_cast(unsigned, f); return (u + 0x7fffu + ((u >> 16) & 1u)) >> 16; }
__device__ __forceinline__ unsigned pk2(float lo, float hi) { return f2bf(lo) | (f2bf(hi) << 16); }
__device__ __forceinline__ float wave_sum(float v) {
#pragma unroll
    for (int o = 1; o < 64; o <<= 1) v += __shfl_xor(v, o);
    return v;
}
__device__ __forceinline__ void transpose_item(const float* W, int N, const float* g, bf16* WT, int Kd, int k0, int n0, int drow0, LAS float* scr, int lane) {
    const float* wp = W + (size_t)(k0 + (lane >> 5)) * N + n0 + (lane & 31);
    float v[32];
#pragma unroll
    for (int i = 0; i < 32; ++i) v[i] = __builtin_nontemporal_load(wp + (size_t)(2 * i) * N);
    const int c = lane & 7;
    f32x4 g0 = {1.f, 1.f, 1.f, 1.f}, g1 = g0;
    if (g) { g0 = *(const f32x4*)(g + k0 + 8 * c); g1 = *(const f32x4*)(g + k0 + 8 * c + 4); }
#pragma unroll
    for (int i = 0; i < 32; ++i) scr[(2 * i + (lane >> 5)) * 33 + (lane & 31)] = v[i];
    LDS_WAIT(); asm volatile("" ::: "memory");
#pragma unroll
    for (int j = 0; j < 4; ++j) { const int n = (lane >> 3) + 8 * j; const LAS float* s = scr + (8 * c) * 33 + n;
        v4u o; o.x = pk2(s[0 * 33] * g0[0], s[1 * 33] * g0[1]); o.y = pk2(s[2 * 33] * g0[2], s[3 * 33] * g0[3]); o.z = pk2(s[4 * 33] * g1[0], s[5 * 33] * g1[1]); o.w = pk2(s[6 * 33] * g1[2], s[7 * 33] * g1[3]);
        *(v4u*)(WT + (size_t)(drow0 + n) * Kd + k0 + 8 * c) = o; }
    LDS_WAIT(); asm volatile("" ::: "memory");
}
struct Args { const float* in[16]; float* out; unsigned char* ws; int ph_lo, ph_hi, coop, pad; };
enum { IN_X = 0, IN_G_FFN1, IN_W1_A, IN_W3_A, IN_W2_A, IN_G_MIX, IN_W_IN, IN_B_GATE, IN_W_SB_OUT, IN_W_DIL_OUT, IN_W_O, IN_G_FFN2, IN_W1_B, IN_W3_B, IN_W2_B, IN_G_FINAL };
constexpr int I_UP = (DMODEL / 64) * (DFF / 32), I_DN = (DFF / 64) * (DMODEL / 32), I_IN = (DMODEL / 64) * (INW / 32), I_SB = (SBW / 64) * (DMODEL / 32), I_DL = (DKVW / 64) * (DMODEL / 32), I_O = (DMODEL / 64) * (DMODEL / 32);
constexpr int CV_A = 0, CV_B = 2 * I_UP, CV_C = CV_B + I_DN + I_IN, CV_D = CV_C + I_SB + I_DL + I_O, CV_END = CV_D + 2 * I_UP + I_DN;
constexpr int CV_D1 = CV_D + 1024, CV_E = CV_D + 2 * I_UP;
__device__ __forceinline__ void convert_range(const Args& P, LAS float* scr, int first, int last, int worker, int nworkers, int lane) {
    unsigned char* ws = P.ws;
    for (int it = first + worker; it < last; it += nworkers) {
        int r = it;
        if (r < CV_B || r >= CV_D) {
            const bool second = r >= CV_D; if (second) r -= CV_D;
            if (r < 2 * I_UP) { const int which = r / I_UP; r -= which * I_UP; const int nblk = DFF / 32, k0 = 64 * (r / nblk), n0 = 32 * (r % nblk);
                const float* W = P.in[(second ? IN_W1_B : IN_W1_A) + which];
                transpose_item(W, DFF, P.in[second ? IN_G_FFN2 : IN_G_FFN1], (bf16*)(ws + (second ? WS_W13B : WS_W13A)), DMODEL, k0, n0, 256 * (n0 / 128) + 128 * which + (n0 % 128), scr, lane); continue; }
            r -= 2 * I_UP; { const int nblk = DMODEL / 32, k0 = 64 * (r / nblk), n0 = 32 * (r % nblk); transpose_item(P.in[IN_W2_B], DMODEL, nullptr, (bf16*)(ws + WS_W2B), DFF, k0, n0, n0, scr, lane); continue; }
        }
        r -= CV_B;
        if (r < I_DN) { const int nblk = DMODEL / 32, k0 = 64 * (r / nblk), n0 = 32 * (r % nblk); transpose_item(P.in[IN_W2_A], DMODEL, nullptr, (bf16*)(ws + WS_W2A), DFF, k0, n0, n0, scr, lane); continue; }
        r -= I_DN;
        if (r < I_IN) { const int nblk = INW / 32, k0 = 64 * (r / nblk), n0 = 32 * (r % nblk); int drow = n0;
            if (n0 >= 1536 && n0 < 2560) { const int a0 = n0 & 255; drow = (n0 & ~255) + 128 * ((a0 >> 5) & 1) + 32 * (a0 >> 6); }
            transpose_item(P.in[IN_W_IN], INW, P.in[IN_G_MIX], (bf16*)(ws + WS_WIN), DMODEL, k0, n0, drow, scr, lane); continue; }
        r -= I_IN;
        if (r < I_SB) { const int nblk = DMODEL / 32, k0 = 64 * (r / nblk), n0 = 32 * (r % nblk); transpose_item(P.in[IN_W_SB_OUT], DMODEL, nullptr, (bf16*)(ws + WS_WSB), SBW, k0, n0, n0, scr, lane); continue; }
        r -= I_SB;
        if (r < I_DL) { const int nblk = DMODEL / 32, k0 = 64 * (r / nblk), n0 = 32 * (r % nblk); transpose_item(P.in[IN_W_DIL_OUT], DMODEL, nullptr, (bf16*)(ws + WS_WDIL), DKVW, k0, n0, n0, scr, lane); continue; }
        r -= I_DL;
        { const int nblk = DMODEL / 32, k0 = 64 * (r / nblk), n0 = 32 * (r % nblk); transpose_item(P.in[IN_W_O], DMODEL, nullptr, (bf16*)(ws + WS_WO), DMODEL, k0, n0, n0, scr, lane); }
    }
}
__device__ __forceinline__ void p0_prologue(const Args& P, LAS unsigned char* lds, int gw, int NGW, int wave, int lane, bool defer) {
    LAS float* scr = (LAS float*)(lds + wave * 16384);
    unsigned char* ws = P.ws;
#ifndef P0_DUP
#define P0_DUP 0
#endif
    for (int dup_ = 0; dup_ < (P0_DUP == 1 ? 2 : 1); ++dup_)
    convert_range(P, scr, CV_A, defer ? CV_B : CV_END, gw, NGW, lane);
    bf16* xb = (bf16*)(ws + WS_XB); float* rowss = (float*)(ws + WS_RSS);
    for (int dup_ = 0; dup_ < (P0_DUP == 2 ? 2 : 1); ++dup_)
    for (int m0 = gw; m0 < MTOK; m0 += 4 * NGW) {
        f32x4 v[4][4];
#pragma unroll
        for (int q = 0; q < 4; ++q) { const f32x4* xr = (const f32x4*)(P.in[IN_X] + (size_t)(m0 + q * NGW) * DMODEL) + lane;
#pragma unroll
            for (int j = 0; j < 4; ++j) v[q][j] = __builtin_nontemporal_load(xr + 64 * j); }
#pragma unroll
        for (int q = 0; q < 4; ++q) { const int m = m0 + q * NGW; float s = 0.f;
#pragma unroll
            for (int j = 0; j < 4; ++j) s += (v[q][j].x * v[q][j].x + v[q][j].y * v[q][j].y) + (v[q][j].z * v[q][j].z + v[q][j].w * v[q][j].w);
            s = wave_sum(s);
            unsigned long long* o8 = (unsigned long long*)(xb + (size_t)m * DMODEL) + lane;
#pragma unroll
            for (int j = 0; j < 4; ++j) o8[64 * j] = (unsigned long long)pk2(v[q][j].x, v[q][j].y) | ((unsigned long long)pk2(v[q][j].z, v[q][j].w) << 32);
            if (lane < 16) rowss[(size_t)m * 16 + lane] = lane == 0 ? s : 0.f; }
    }
    float* ropec = (float*)(ws + WS_ROPE); float* ropes = ropec + SEQ * 32;
    for (int dup_ = 0; dup_ < (P0_DUP == 3 ? 2 : 1); ++dup_)
    for (int e = gw * 64 + lane; e < SEQ * 32; e += NGW * 64) { const int pos = e >> 5, i = e & 31;
        const float invf = powf(10000.0f, -(float)i / 32.0f); const float ang = (float)pos * invf;
        double rev = (double)ang * 0.15915494309189535; rev -= __builtin_rint(rev); const float fr = (float)rev;
        ropec[e] = __builtin_amdgcn_cosf(fr); ropes[e] = __builtin_amdgcn_sinf(fr); }
}
__device__ __forceinline__ int crow(int r, int hi) { return (r & 3) + 8 * (r >> 2) + 4 * hi; }
__device__ __forceinline__ unsigned cvtpk(float lo, float hi) { return pg8::cvt_pk_bf16(lo, hi); }
__device__ __forceinline__ s16x8 pack_p(const f32x16& p, int c) { v4u w; w.x = cvtpk(p[8 * c + 0], p[8 * c + 1]); w.y = cvtpk(p[8 * c + 2], p[8 * c + 3]); w.z = cvtpk(p[8 * c + 4], p[8 * c + 5]); w.w = cvtpk(p[8 * c + 6], p[8 * c + 7]); return __builtin_bit_cast(s16x8, w); }
constexpr int VT_PITCH = 96, VT_BYTES = 32 * VT_PITCH * 2;
typedef short v4i16_t __attribute__((ext_vector_type(4)));
struct VRegs { s16x8 t[4]; };
__device__ __forceinline__ void vload(VRegs& v, const bf16* vsrc  , unsigned rstride, int lane) {
    const bf16* p = vsrc + (size_t)((unsigned)(lane >> 1) * rstride + (unsigned)(lane & 1) * 32u);
#pragma unroll
    for (int i = 0; i < 4; ++i) v.t[i] = *(const s16x8*)(p + 8 * i);
}
__device__ __forceinline__ void vfrags(s16x8 (&vf)[2][2], const VRegs& v, LAS bf16* vt, int lane) {
    const int r32 = lane & 31, hi = lane >> 5;
    asm volatile("s_waitcnt lgkmcnt(0)" ::: "memory");
    LAS bf16* wp = vt + (lane >> 1) * VT_PITCH + (lane & 1) * 32;
#pragma unroll
    for (int i = 0; i < 4; ++i) *(LAS s16x8*)(wp + 8 * i) = v.t[i];
    asm volatile("s_waitcnt lgkmcnt(0)" ::: "memory");
    const int grp = lane >> 4, q = (lane & 15) >> 2, p = lane & 3;
    const LAS bf16* rp = vt + (4 * (grp >> 1) + q) * VT_PITCH + 16 * (grp & 1) + 4 * p;
#pragma unroll
    for (int c = 0; c < 2; ++c)
#pragma unroll
        for (int db = 0; db < 2; ++db) {
            const v4i16_t lo = __builtin_amdgcn_ds_read_tr16_b64_v4i16((LAS v4i16_t*)(rp + (16 * c) * VT_PITCH + 32 * db)), hi8 = __builtin_amdgcn_ds_read_tr16_b64_v4i16((LAS v4i16_t*)(rp + (16 * c + 8) * VT_PITCH + 32 * db));
            vf[db][c] = (s16x8){lo[0], lo[1], lo[2], lo[3], hi8[0], hi8[1], hi8[2], hi8[3]}; }
}
__device__ __forceinline__ void store_o(bf16* ob  , unsigned rstride, const f32x16& o0, const f32x16& o1, LAS bf16* vt, int lane) {
    const int r32 = lane & 31, hi = lane >> 5;
    asm volatile("s_waitcnt lgkmcnt(0)" ::: "memory");
    LAS bf16* wp = vt + 4 * hi * VT_PITCH + r32;
#pragma unroll
    for (int r = 0; r < 16; ++r) { const int row = (r & 3) + 8 * (r >> 2); const unsigned w = cvtpk(o0[r], o1[r]); wp[row * VT_PITCH] = (bf16)(w & 0xffffu); wp[row * VT_PITCH + 32] = (bf16)(w >> 16); }
    asm volatile("s_waitcnt lgkmcnt(0)" ::: "memory");
    const LAS bf16* rp = vt + (lane >> 1) * VT_PITCH + (lane & 1) * 32;
    bf16* gp = ob + (size_t)((unsigned)(lane >> 1) * rstride + (unsigned)(lane & 1) * 32u);
#pragma unroll
    for (int i = 0; i < 4; ++i) *(s16x8*)(gp + 8 * i) = *(const LAS s16x8*)(rp + 8 * i);
}
__device__ __forceinline__ void kload(s16x8 (&kf)[4], const bf16* ksrc  , unsigned rstride, int lane) {
    const bf16* p = ksrc + (size_t)((unsigned)(lane & 31) * rstride + (unsigned)(lane >> 5) * 8u);
#pragma unroll
    for (int d0 = 0; d0 < 4; ++d0) kf[d0] = *(const s16x8*)(p + 16 * d0);
}
__device__ __forceinline__ void sb_item(int item, const bf16* QO, bf16* OUT, const bf16* K, const bf16* V, LAS bf16* vt, int lane) {
    const int r32 = lane & 31, hi = lane >> 5;
    const int qb = 255 - (item & 255), h = (item >> 8) & 7, b = item >> 11;
    const int t0 = qb * 32; const size_t rowb = (size_t)b * SEQ;
    s16x8 qr[4]; kload(qr, QO + (rowb + t0) * SBW + h * 64, SBW, lane);
    const bf16* Kh = K + rowb * SBW + h * 64; const bf16* Vh = V + rowb * SBW + h * 64;
    f32x16 o0 = {}, o1 = {}; float carry = 1.f;
    s16x8 kn[4]; VRegs vn; kload(kn, Kh + (size_t)t0 * SBW, SBW, lane); vload(vn, Vh + (size_t)t0 * SBW, SBW, lane);
    for (int kb = t0; kb >= 0; kb -= 32) {
        s16x8 kf[4]; VRegs vc;
#pragma unroll
        for (int d0 = 0; d0 < 4; ++d0) { kf[d0] = kn[d0]; vc.t[d0] = vn.t[d0]; }
        if (kb >= 32) { kload(kn, Kh + (size_t)(kb - 32) * SBW, SBW, lane); vload(vn, Vh + (size_t)(kb - 32) * SBW, SBW, lane); }
        f32x16 s = {};
#pragma unroll
        for (int d0 = 0; d0 < 4; ++d0) s = __builtin_amdgcn_mfma_f32_32x32x16_bf16(kf[d0], qr[d0], s, 0, 0, 0);
        float be[16], nb[16];
#pragma unroll
        for (int r = 0; r < 16; ++r) { const float e = __builtin_amdgcn_exp2f(-__builtin_fmaxf(s[r], -126.0f)); const float rc = __builtin_amdgcn_rcpf(1.0f + e); be[r] = rc; nb[r] = e * rc; }
        if (kb == t0) {
#pragma unroll
            for (int r = 0; r < 16; ++r) if (!(crow(r, hi) < r32)) { be[r] = 0.f; nb[r] = 1.f; }
        }
        float tot[4], pg[4];
#pragma unroll
        for (int g = 0; g < 4; ++g) { const float gs = (nb[4 * g] * nb[4 * g + 1]) * (nb[4 * g + 2] * nb[4 * g + 3]); pg[g] = __shfl_xor(gs, 32); tot[g] = gs * pg[g]; }
        float T[4]; T[3] = 1.f; T[2] = tot[3]; T[1] = T[2] * tot[2]; T[0] = T[1] * tot[1]; const float total = T[0] * tot[0];
        f32x16 a;
#pragma unroll
        for (int g = 0; g < 4; ++g) { const float w3 = carry * T[g] * (hi == 0 ? pg[g] : 1.f), w2 = w3 * nb[4 * g + 3], w1 = w2 * nb[4 * g + 2], w0 = w1 * nb[4 * g + 1];
            a[4 * g + 0] = be[4 * g + 0] * w0; a[4 * g + 1] = be[4 * g + 1] * w1; a[4 * g + 2] = be[4 * g + 2] * w2; a[4 * g + 3] = be[4 * g + 3] * w3; }
        carry *= total;
        const s16x8 pa0 = pack_p(a, 0), pa1 = pack_p(a, 1);
        s16x8 vf[2][2]; vfrags(vf, vc, vt, lane);
        o0 = __builtin_amdgcn_mfma_f32_32x32x16_bf16(pa0, vf[0][0], o0, 0, 0, 0); o0 = __builtin_amdgcn_mfma_f32_32x32x16_bf16(pa1, vf[0][1], o0, 0, 0, 0);
        o1 = __builtin_amdgcn_mfma_f32_32x32x16_bf16(pa0, vf[1][0], o1, 0, 0, 0); o1 = __builtin_amdgcn_mfma_f32_32x32x16_bf16(pa1, vf[1][1], o1, 0, 0, 0);
        if (__all(carry < 1e-37f)) break;
    }
    store_o(OUT + (rowb + t0) * SBW + h * 64, SBW, o0, o1, vt, lane);
}
__device__ __forceinline__ void dl_item(int item, const bf16* QO, bf16* OUT, const bf16* K, const bf16* V, float* LSE, LAS bf16* vt, int lane) {
    const int r32 = lane & 31, hi = lane >> 5;
    const int g = item >> 11, rem = item & 2047, b = rem >> 10, j = (rem >> 8) & 3, blk = rem & 255;
    const int dsh = 2 * g, dil = 1 << dsh, nsb = 256 >> dsh, rr = blk / nsb, i0 = (blk % nsb) * 32;
    const size_t rowb = (size_t)b * SEQ + rr;
    const unsigned qstride = (unsigned)dil * DQW, kstride = (unsigned)dil * DKVW;
    const size_t qoff = (rowb + (size_t)dil * i0) * DQW + (g * 4 + j) * 64; const bf16* Qb = QO + qoff;
    s16x8 qr[4]; kload(qr, Qb, qstride, lane);
    const bf16* Kh = K + rowb * DKVW + j * 64; const bf16* Vh = V + rowb * DKVW + j * 64;
    f32x16 sc[5]; float mx = -INFINITY; const float flim = (float)(r32 - 4 * hi);
    const int n0 = i0 >= 128 ? 0 : (128 - i0) >> 5;
    s16x8 kf[5][4];
#pragma unroll
    for (int n = 0; n < 5; ++n) { const int nn = n < n0 ? n0 : n; kload(kf[n], Kh + (size_t)(i0 - 128 + 32 * nn) * kstride, kstride, lane); }
    VRegs vn; vload(vn, Vh + (size_t)(i0 - 128 + 32 * n0) * kstride, kstride, lane);
#pragma unroll
    for (int n = 0; n < 5; ++n) {
        f32x16 s = {};
#pragma unroll
        for (int d0 = 0; d0 < 4; ++d0) s = __builtin_amdgcn_mfma_f32_32x32x16_bf16(kf[n][d0], qr[d0], s, 0, 0, 0);
        const float dead = n < n0 ? -INFINITY : INFINITY;
#pragma unroll
        for (int r = 0; r < 16; ++r) {
            if (n == 0) s[r] = __builtin_fminf(s[r], ((float)((r & 3) + 8 * (r >> 2)) - flim + 0.5f) * 6e38f);
            if (n == 4) s[r] = __builtin_fminf(s[r], (flim - (float)((r & 3) + 8 * (r >> 2)) + 0.5f) * 6e38f);
            if (n < 4) s[r] = __builtin_fminf(s[r], dead);
            mx = __builtin_fmaxf(mx, s[r]); }
        sc[n] = s;
    }
    mx = __builtin_fmaxf(mx, __shfl_xor(mx, 32));
    float l = 0.f;
#pragma unroll
    for (int n = 0; n < 5; ++n)
#pragma unroll
        for (int r = 0; r < 16; ++r) { const float p = __builtin_amdgcn_exp2f(sc[n][r] - mx); sc[n][r] = p; l += p; }
    l += __shfl_xor(l, 32);
    const float inv = 1.0f / l;
    f32x16 o0 = {}, o1 = {};
#pragma unroll
    for (int n = 0; n < 5; ++n) {
        if (n >= n0) {
            VRegs vc;
#pragma unroll
            for (int q = 0; q < 4; ++q) vc.t[q] = vn.t[q];
            if (n < 4) vload(vn, Vh + (size_t)(i0 - 128 + 32 * (n + 1)) * kstride, kstride, lane);
            f32x16 p = sc[n] * inv;
            const s16x8 pa0 = pack_p(p, 0), pa1 = pack_p(p, 1);
            s16x8 vf[2][2]; vfrags(vf, vc, vt, lane);
            o0 = __builtin_amdgcn_mfma_f32_32x32x16_bf16(pa0, vf[0][0], o0, 0, 0, 0); o0 = __builtin_amdgcn_mfma_f32_32x32x16_bf16(pa1, vf[0][1], o0, 0, 0, 0);
            o1 = __builtin_amdgcn_mfma_f32_32x32x16_bf16(pa0, vf[1][0], o1, 0, 0, 0); o1 = __builtin_amdgcn_mfma_f32_32x32x16_bf16(pa1, vf[1][1], o1, 0, 0, 0);
        }
    }
    store_o(OUT + qoff, qstride, o0, o1, vt, lane);
    if (hi == 0) LSE[((size_t)g * MTOK + rowb + (size_t)dil * (i0 + r32)) * 4 + j] = mx + __builtin_amdgcn_logf(l);
}
__device__ __forceinline__ void combine_rows(int pm, const bf16* O, const float* LSE, bf16* YDL, int tid) {
#pragma unroll 4
    for (int k = 0; k < 16; ++k) { const int c = tid + NTHREADS * k, row = pm * 256 + (c >> 5), cc = c & 31, j = cc >> 3;
        const float l0 = LSE[((size_t)0 * MTOK + row) * 4 + j], l1 = LSE[((size_t)1 * MTOK + row) * 4 + j], l2 = LSE[((size_t)2 * MTOK + row) * 4 + j];
        const float M = __builtin_fmaxf(l0, __builtin_fmaxf(l1, l2)); float w0 = __builtin_amdgcn_exp2f(l0 - M), w1 = __builtin_amdgcn_exp2f(l1 - M), w2 = __builtin_amdgcn_exp2f(l2 - M);
        const float inv = 1.0f / (w0 + w1 + w2); w0 *= inv; w1 *= inv; w2 *= inv;
        const bf16* op = O + (size_t)row * DQW + cc * 8;
        const v4u a = *(const v4u*)op, bq = *(const v4u*)(op + 256), cq = *(const v4u*)(op + 512);
        v4u o;
#define CMB(x) pk2(w0 * pg8::bf_lo(a.x) + w1 * pg8::bf_lo(bq.x) + w2 * pg8::bf_lo(cq.x), w0 * pg8::bf_hi(a.x) + w1 * pg8::bf_hi(bq.x) + w2 * pg8::bf_hi(cq.x))
        o.x = CMB(x); o.y = CMB(y); o.z = CMB(z); o.w = CMB(w);
#undef CMB
        *(v4u*)(YDL + (size_t)row * DKVW + cc * 8) = o; }
}


__device__ __forceinline__ int mk_lane() { int t = (int)threadIdx.x; asm volatile("" : "+v"(t)); return t & 63; }
constexpr int NPHASES = 10;
__global__ void __launch_bounds__(NTHREADS, 2) mk_fwd(Args args) {
    extern __shared__ __attribute__((aligned(16))) unsigned char lds_raw[];
    LAS unsigned char* lds = (LAS unsigned char*)lds_raw;
    cg::grid_group grid = cg::this_grid();
    const int tid = threadIdx.x, wave = __builtin_amdgcn_readfirstlane(tid >> 6);
#define lane mk_lane()
    const int G = gridDim.x, gw = blockIdx.x * NWAVES + wave, NGW = G * NWAVES;
    unsigned char* ws = args.ws;
#define xb ((bf16*)(ws + WS_XB))
#define rowss ((float*)(ws + WS_RSS))
#define U ((bf16*)(ws + WS_U))
#define qsb ((bf16*)(ws + WS_QSB))
#define ksb ((bf16*)(ws + WS_KSB))
#define vsb ((bf16*)(ws + WS_VSB))
#define qdl ((bf16*)(ws + WS_QDL))
#define kdl ((bf16*)(ws + WS_KDL))
#define vdl ((bf16*)(ws + WS_VDL))
#define gates ((bf16*)(ws + WS_GATES))
#define mbuf ((bf16*)(ws + WS_MBUF))
#define ydl ((bf16*)(ws + WS_YDL))
#define lse ((float*)(ws + WS_LSE))
    const int lo = args.ph_lo, hi = args.ph_hi;
#ifndef PHMASK
#define PHMASK 0x3ff
#endif
#define IN(k) (((PHMASK >> (k)) & 1) && lo <= (k) && (k) < hi)
#define GBAR() do { if (args.coop) xcd_barrier(xbar); } while (0)
#ifndef DEFER_CVT
#define DEFER_CVT 1
#endif
#ifndef FUSE_FINAL
#define FUSE_FINAL 1
#endif
#define SEAM(k) do { if ((k) == 8 && FUSE_FINAL && args.coop && G == 256) break; if (IN(k) && IN((k) + 1)) { if ((k) == 0 && args.coop == 2) grid.sync(); else GBAR(); } } while (0)
    XcdBarrier xbar; xbar.bar = (unsigned*)(ws + WS_CTL); xbar.x = 0; xbar.st = (volatile LAS unsigned*)(lds + LDSCTL_OFF);
    if (tid < 2) ((LAS unsigned*)(lds + LDSCTL_OFF))[tid] = 0u;
    __syncthreads();
    if (args.coop) xbar = xcd_barrier_post((unsigned*)(ws + WS_CTL), (volatile LAS unsigned*)(lds + LDSCTL_OFF));
    LAS unsigned long long* tstamp = (LAS unsigned long long*)(lds + LDSCTL_OFF + 1024);
#define STAMP(i) do { if (TS_A >= 0 && blockIdx.x == 0 && tid == 0) tstamp[i] = __builtin_amdgcn_s_memrealtime(); } while (0)
    STAMP(0);
#ifndef REPEAT_PH
#define REPEAT_PH -1
#endif
#define REP(k) for (int rep_ = (REPEAT_PH == (k)) ? 0 : 1; rep_ < 2; ++rep_)
#define REPBAR(k) do { if (REPEAT_PH == (k) && rep_ == 0) GBAR(); } while (0)

    const bool defer = DEFER_CVT && args.coop && G == 256;
    if (IN(0)) REP(0) {
        p0_prologue(args, lds, gw, NGW, wave, lane, defer); __syncthreads(); if (REPEAT_PH == 0 && rep_ == 0 && args.coop) GBAR(); }
    SEAM(0); STAMP(1);
#define PBODY1 { pg8::Gemm g{xb, (const bf16*)(ws + WS_W13A), MTOK, 2 * DFF, DMODEL}; pg8::StaticOrder S; S.init(MTOK, 2 * DFF, G, (int)blockIdx.x);         pg8::Unit u0_; int tpm_ = -1; if (S.next(0, u0_)) { tpm_ = u0_.pm; pg8::rstd_table((LAS float*)(lds + pg8::RSTAB_OFF), rowss, tpm_); } pg8::EpiSwiglu E{U, rowss, (LAS const float*)(lds + pg8::RSTAB_OFF), tpm_}; pg8::gemm_phase<pg8::EpiSwiglu, pg8::StaticOrder, true, true>(lds, g, S, E); }
    if (IN(1)) { if (REPEAT_PH == 1) { PBODY1; GBAR(); } PBODY1;
        if (defer && blockIdx.x >= 128) { convert_range(args, (LAS float*)(lds + wave * 16384), CV_B, CV_C, ((int)blockIdx.x - 128) * NWAVES + wave, 128 * NWAVES, lane); } }
    SEAM(1); STAMP(2);
#define PBODY2 { pg8::Gemm g{U, (const bf16*)(ws + WS_W2A), MTOK, DMODEL, DFF}; pg8::StaticOrder S; S.init(MTOK, DMODEL, G, (int)blockIdx.x);         pg8::EpiResid<true, false> E{xb, xb, rowss, 0.5f}; pg8::gemm_phase<pg8::EpiResid<true, false>, pg8::StaticOrder, true, true>    (lds, g, S, E); }
    if (IN(2)) { if (REPEAT_PH == 2) { PBODY2; GBAR(); } PBODY2; }
    SEAM(2); STAMP(3);
#define PBODY3 { pg8::Gemm g{xb, (const bf16*)(ws + WS_WIN), MTOK, INW, DMODEL}; pg8::StaticOrder S; S.init(MTOK, INW, G, (int)blockIdx.x);         pg8::Unit u0_; int tpm_ = -1; if (S.next(0, u0_)) { tpm_ = u0_.pm; pg8::rstd_table((LAS float*)(lds + pg8::RSTAB_OFF), rowss, tpm_); } pg8::EpiInProj E{ws, args.in[7], (LAS const float*)(lds + pg8::RSTAB_OFF), tpm_}; pg8::gemm_phase<pg8::EpiInProj, pg8::StaticOrder, true, true>(lds, g, S, E); }
    if (IN(3)) { if (REPEAT_PH == 3) { PBODY3; GBAR(); } PBODY3;
        if (defer && blockIdx.x >= 192) { convert_range(args, (LAS float*)(lds + wave * 16384), CV_C, CV_D1, ((int)blockIdx.x - 192) * NWAVES + wave, 64 * NWAVES, lane); } }
    SEAM(3); STAMP(4);
    if (IN(4)) REP(4) {
        bf16* osb = (REPEAT_PH == 4 && rep_ == 0) ? (bf16*)(ws + WS_XB) : qsb; bf16* odl = (REPEAT_PH == 4 && rep_ == 0) ? (bf16*)(ws + WS_XB) : qdl;
        constexpr int N_DL = 3 * 2048, N_SB = 2 * 8 * 256; LAS bf16* vt = (LAS bf16*)(lds + wave * 8192); const int lane4 = lane;
        for (int it = gw; it < N_DL + N_SB; it += NGW) {
#ifndef NO_DL
            if (it < N_DL) dl_item(it, qdl, odl, kdl, vdl, lse, vt, lane4);
#endif
#ifndef NO_SB
            if (it >= N_DL) sb_item(it - N_DL, qsb, osb, ksb, vsb, vt, lane4);
#endif
 }
        if (defer && !(REPEAT_PH == 4 && rep_ == 0)) { convert_range(args, (LAS float*)(lds + 65536 + wave * 8448), CV_D1, CV_E, gw, NGW, lane4); }
        REPBAR(4);
    }
    SEAM(4); STAMP(5);
#define PBODY5 { pg8::StaticOrder S; S.init(MTOK, DMODEL, G, (int)blockIdx.x); pg8::Unit u; for (int dup_ = 0; dup_ < (P0_DUP == 5 ? 2 : 1); ++dup_) for (int i = 0; S.next(i, u); ++i) combine_rows(u.pm, qdl, lse, ydl, tid); asm volatile("s_waitcnt vmcnt(0)" ::: "memory"); __syncthreads(); { pg8::Gemm g{qsb, (const bf16*)(ws + WS_WSB), MTOK, DMODEL, SBW}; pg8::EpiGate<false> E{mbuf, gates, 0}; pg8::gemm_phase<pg8::EpiGate<false>, pg8::StaticOrder, true, true>(lds, g, S, E); } asm volatile("s_waitcnt vmcnt(0)" ::: "memory"); __syncthreads(); { pg8::Gemm g{ydl, (const bf16*)(ws + WS_WDIL), MTOK, DMODEL, DKVW}; pg8::EpiGate<true> E{mbuf, gates, DMODEL}; pg8::gemm_phase<pg8::EpiGate<true>, pg8::StaticOrder, true, true>(lds, g, S, E); } }
    if (IN(5)) { if (REPEAT_PH == 5) { PBODY5; GBAR(); } PBODY5; }
    SEAM(5); STAMP(6);
    if (IN(6)) { pg8::Gemm g{mbuf, (const bf16*)(ws + WS_WO), MTOK, DMODEL, DMODEL}; pg8::StaticOrder S; S.init(MTOK, DMODEL, G, (int)blockIdx.x);
        pg8::EpiResid<true, false> E{xb, xb, rowss, 1.0f}; pg8::gemm_phase<pg8::EpiResid<true, false>, pg8::StaticOrder, true, true>(lds, g, S, E); }
    SEAM(6); STAMP(7);
    if (REPEAT_PH == 10) { GBAR(); GBAR(); GBAR(); GBAR(); }
#define PBODY7 { pg8::Gemm g{xb, (const bf16*)(ws + WS_W13B), MTOK, 2 * DFF, DMODEL}; pg8::StaticOrder S; S.init(MTOK, 2 * DFF, G, (int)blockIdx.x);         pg8::Unit u0_; int tpm_ = -1; if (S.next(0, u0_)) { tpm_ = u0_.pm; pg8::rstd_table((LAS float*)(lds + pg8::RSTAB_OFF), rowss, tpm_); } pg8::EpiSwiglu E{U, rowss, (LAS const float*)(lds + pg8::RSTAB_OFF), tpm_}; pg8::gemm_phase<pg8::EpiSwiglu, pg8::StaticOrder, true, true>(lds, g, S, E); }
    if (IN(7)) { if (REPEAT_PH == 7) { PBODY7; GBAR(); } PBODY7;
        if (defer && blockIdx.x >= 128) { convert_range(args, (LAS float*)(lds + wave * 16384), CV_E, CV_END, ((int)blockIdx.x - 128) * NWAVES + wave, 128 * NWAVES, lane); } }
    SEAM(7); STAMP(8);
    if (IN(8)) { pg8::Gemm g{U, (const bf16*)(ws + WS_W2B), MTOK, DMODEL, DFF}; pg8::StaticOrder S; S.init(MTOK, DMODEL, G, (int)blockIdx.x);
        if (FUSE_FINAL && args.coop && G == 256) { pg8::EpiResidNorm E{xb, args.out, rowss, args.in[15], 0.5f, xbar}; pg8::gemm_phase<pg8::EpiResidNorm, pg8::StaticOrder, false, true>(lds, g, S, E); }
        else { pg8::EpiResid<true, true> E{xb, args.out, nullptr, 0.5f}; pg8::gemm_phase<pg8::EpiResid<true, true>, pg8::StaticOrder, true, true>(lds, g, S, E); } }
    SEAM(8); STAMP(9);
    if (IN(9) && !(FUSE_FINAL && args.coop && G == 256)) {
        if (TS_A >= 0) __syncthreads();
        const int lane9 = lane;
        const f32x4* gr = (const f32x4*)args.in[15] + lane9; f32x4 gv[4];
#pragma unroll
        for (int j = 0; j < 4; ++j) gv[j] = gr[64 * j];
        for (int m0 = gw; m0 < MTOK; m0 += 4 * NGW) {
            f32x4 v[4][4];
#pragma unroll
            for (int q = 0; q < 4; ++q) { const f32x4* xr = (const f32x4*)(args.out + (size_t)(m0 + q * NGW) * DMODEL) + lane9;
#pragma unroll
                for (int j = 0; j < 4; ++j) v[q][j] = xr[64 * j]; }
#pragma unroll
            for (int q = 0; q < 4; ++q) { const int m = m0 + q * NGW; f32x4* xr = (f32x4*)(args.out + (size_t)m * DMODEL) + lane9; float s = 0.f;
#pragma unroll
                for (int j = 0; j < 4; ++j) s += (v[q][j].x * v[q][j].x + v[q][j].y * v[q][j].y) + (v[q][j].z * v[q][j].z + v[q][j].w * v[q][j].w);
                const float rstd = 1.0f / sqrtf(wave_sum(s) * (1.0f / DMODEL) + RMS_EPS);
#pragma unroll
                for (int j = 0; j < 4; ++j) { f32x4 o = v[q][j] * rstd * gv[j];
                    if (TS_A >= 0 && blockIdx.x == 0) {
                        const unsigned nper = (unsigned)((tstamp[TS_B] - tstamp[TS_A]) * 64ull / 100ull); const unsigned base = (unsigned)(((m / NGW) * 8 + wave) * 1024 + 256 * j + 4 * lane9);
#pragma unroll
                        for (int c = 0; c < 4; ++c) if (base + c < nper) o[c] += 0.05f; }
                    xr[64 * j] = o; } }
        }
    }
#undef IN
#undef SEAM
#undef lane
#undef xb
#undef rowss
#undef U
#undef qsb
#undef ksb
#undef vsb
#undef qdl
#undef kdl
#undef vdl
#undef gates
#undef mbuf
#undef ydl
#undef lse
}

#ifndef MK_SINGLE
#define MK_SINGLE 1
#endif
extern "C" void kernel_launch(void* const* d_in, const int* in_sizes, int n_in, void* d_out, int out_size, void* d_ws, size_t ws_size, hipStream_t stream) {
    static int grid = 0;
    if (grid == 0) {
        if (n_in != 16 || in_sizes[0] != MTOK * DMODEL || out_size != MTOK * DMODEL || ws_size < WS_END) { fprintf(stderr, "kernel_launch: unexpected shapes (n_in %d, in0 %d, out %d, ws %zu)\n", n_in, n_in > 0 ? in_sizes[0] : -1, out_size, ws_size); grid = -1; return; }
        int dev = 0, cus = 0, per_cu = 0;
        hipGetDevice(&dev); hipDeviceGetAttribute(&cus, hipDeviceAttributeMultiprocessorCount, dev);
        if (hipFuncSetAttribute((const void*)mk_fwd, hipFuncAttributeMaxDynamicSharedMemorySize, LDS_BYTES) != hipSuccess) { fprintf(stderr, "kernel_launch: hipFuncSetAttribute failed\n"); grid = -1; return; }
        if (hipOccupancyMaxActiveBlocksPerMultiprocessor(&per_cu, (const void*)mk_fwd, NTHREADS, LDS_BYTES) != hipSuccess || per_cu < 1) { fprintf(stderr, "kernel_launch: occupancy query says %d\n", per_cu); per_cu = 1; }
        (void)hipGetLastError();
        grid = cus * 1;
    }
    if (grid < 0) return;
    Args a{};
    for (int i = 0; i < 16; ++i) a.in[i] = (const float*)d_in[i];
    a.out = (float*)d_out; a.ws = (unsigned char*)d_ws;
#if MK_SINGLE
    a.ph_lo = 0; a.ph_hi = NPHASES; a.coop = 1;
    if (hipMemsetAsync((unsigned char*)d_ws + WS_CTL, 0, 16384, stream) != hipSuccess) { fprintf(stderr, "kernel_launch: hipMemsetAsync of the barrier words failed\n"); return; }
    void* kargs[] = {&a};
    hipError_t e = hipLaunchCooperativeKernel((const void*)mk_fwd, dim3(grid), dim3(NTHREADS), kargs, LDS_BYTES, stream);
    if (e != hipSuccess) fprintf(stderr, "kernel_launch: cooperative launch failed: %s (grid %d)\n", hipGetErrorString(e), grid);
#else
    for (int p = 0; p < NPHASES; ++p) { a.ph_lo = p; a.ph_hi = p + 1; a.coop = 0; hipLaunchKernelGGL(mk_fwd, dim3(grid), dim3(NTHREADS), LDS_BYTES, stream, a); }
#endif
}
```

```cpp
#include <hip/hip_runtime.h>
#include <hip/hip_cooperative_groups.h>
#include <cstdio>
#include <cstdint>
namespace cg = cooperative_groups;

constexpr int MTOK = 16384, SEQ = 8192, DMODEL = 1024, DFF = 2816, SBW = 512, DQW = 768, DKVW = 256, INW = 4864;
constexpr float RMS_EPS = 1e-6f;
constexpr float LOG2E = 1.4426950408889634f;
constexpr float QSCALE = 0.125f * 1.4426950408889634f;

constexpr size_t WSO_ROPE = 46u << 20, WSO_RSS = 48u << 20, WSO_QSB = 89u << 20, WSO_KSB = 105u << 20, WSO_VSB = 121u << 20, WSO_QDL = 137u << 20, WSO_KDL = 161u << 20, WSO_VDL = 169u << 20, WSO_GATES = 177u << 20;
#ifndef TS_A
#define TS_A -1
#define TS_B -1
#endif
#define LAS __attribute__((address_space(3)))
#define XB_TMO      128
#define XB_XCNT(j)  (256  + 64 * (j))
#define XB_XSUB(j)  (1280 + 64 * (j))
#define XB_XGEN(j)  (2304 + 64 * (j))
#define XB_TOP      3328
#define XB_TOPGEN   3392
#define XCD_BAR_WORDS 3456
#define XB_SPIN_CAP (1u << 18)

__device__ __forceinline__ unsigned xb_ld(unsigned* p)              { return __hip_atomic_load(p, __ATOMIC_RELAXED, __HIP_MEMORY_SCOPE_AGENT); }
__device__ __forceinline__ unsigned xb_add(unsigned* p, unsigned v) { return __hip_atomic_fetch_add(p, v, __ATOMIC_RELAXED, __HIP_MEMORY_SCOPE_AGENT); }
__device__ __forceinline__ unsigned xb_xcc_id() { return (unsigned)__builtin_amdgcn_s_getreg((3 << 11) | 20) & 0xFu; }
#define XB_SPIN(cond, bar) do { unsigned _sp = 0; while (cond) { __builtin_amdgcn_s_sleep(1); \
    if ((++_sp & 255u) == 0u) { if (xb_ld(&(bar)[XB_TMO])) break; if (_sp > XB_SPIN_CAP) { atomicAdd(&(bar)[XB_TMO], 1u); break; } } } } while (0)

struct XcdBarrier {
    unsigned* bar; unsigned x;
    volatile LAS unsigned* st;
};

__device__ __forceinline__ XcdBarrier xcd_barrier_post(unsigned* bar, volatile LAS unsigned* st) {
    XcdBarrier b; b.bar = bar; b.x = xb_xcc_id(); b.st = st;
    if (threadIdx.x == 0) (void)xb_add(&bar[XB_XCNT(b.x)], 1u);
    return b;
}
__device__ __forceinline__ void xcd_barrier_complete(unsigned* bar, unsigned x, unsigned& nloc, unsigned& nx) {
    const unsigned G = gridDim.x * gridDim.y * gridDim.z;
    unsigned sum, cnt, mine, sp = 0u;
    for (;;) {
        sum = 0u; cnt = 0u; mine = 0u;
#pragma unroll
        for (unsigned j = 0; j < 16; ++j) { const unsigned c = xb_ld(&bar[XB_XCNT(j)]); sum += c; cnt += (c > 0u) ? 1u : 0u; mine = (j == x) ? c : mine; }
        if (sum == G) break;
        __builtin_amdgcn_s_sleep(1);
        if ((++sp & 255u) == 0u) { if (xb_ld(&bar[XB_TMO])) break; if (sp > XB_SPIN_CAP) { atomicAdd(&bar[XB_TMO], 1u); break; } }
    }
    nloc = mine > 0u ? mine : 1u; nx = cnt > 0u ? cnt : 1u;
}

__device__ __forceinline__ void xcd_barrier(const XcdBarrier& b) {
    asm volatile("s_waitcnt vmcnt(0)" ::: "memory");
    __syncthreads();
    if (threadIdx.x == 0) {
        unsigned* bar = b.bar;
        __builtin_amdgcn_s_waitcnt(0);
        unsigned nloc = b.st[0], nx = b.st[1];
        if (nloc == 0u) { xcd_barrier_complete(bar, b.x, nloc, nx); b.st[0] = nloc; b.st[1] = nx; }
        const unsigned old = xb_add(&bar[XB_XSUB(b.x)], 1u);
        const unsigned gen = old / nloc;
        if (old + 1u == (gen + 1u) * nloc) {
            __builtin_amdgcn_fence(__ATOMIC_RELEASE, "agent");
            asm volatile("s_waitcnt vmcnt(0)" ::: "memory");
            const unsigned og = xb_add(&bar[XB_TOP], 1u);
            const unsigned tg = og / nx;
            if (og + 1u == (tg + 1u) * nx) xb_add(&bar[XB_TOPGEN], 1u);
            else XB_SPIN(xb_ld(&bar[XB_TOPGEN]) == tg, bar);
            __builtin_amdgcn_fence(__ATOMIC_ACQUIRE, "agent");
            xb_add(&bar[XB_XGEN(b.x)], 1u);
            asm volatile("s_waitcnt vmcnt(0)" ::: "memory");
        } else {
            XB_SPIN(xb_ld(&bar[XB_XGEN(b.x)]) == gen, bar);
            __builtin_amdgcn_fence(__ATOMIC_ACQUIRE, "agent");
            asm volatile("s_waitcnt vmcnt(0)" ::: "memory");
        }
    }
    __syncthreads();
}

namespace pg8 {
#define PG8_LAS __attribute__((address_space(3)))
typedef unsigned short bf16_t;
typedef short bf16x8 __attribute__((ext_vector_type(8)));
typedef float f32x4 __attribute__((ext_vector_type(4)));
typedef unsigned u32x4 __attribute__((ext_vector_type(4)));
constexpr int BM = 256, BK = 64, HALF = 128, HTB = HALF * BK * 2  , STAGE_BYTES = 8 * HTB, NXCD = 8, WGM = 8;

__host__ __device__ __forceinline__ int lds_byte(int r, int c) { const int st = (r >> 4) * 2 + (c >> 5), rr = r & 15, cc = c & 31, ob = rr * 64 + cc * 2; return st * 1024 + (ob ^ (((ob >> 9) & 1) << 5)); }
__host__ __device__ __forceinline__ void stage_rc(int b, int& R, int& C) { const int st = b / 1024, sb = b % 1024, swz = sb ^ (((sb >> 9) & 1) << 5); R = (st >> 1) * 16 + swz / 64; C = (st & 1) * 32 + (swz % 64) / 2; }
__host__ __device__ __forceinline__ int perm32(int rho) { const int n = rho >> 4, i = rho & 15; return 8 * (i >> 2) + 4 * n + (i & 3); }

struct Unit { int pm, pn; };
struct Gemm { const bf16_t* A; const bf16_t* Bt; int M, N, K; };

struct StaticOrder {
    int nM, nN, nwg, G, c;
    __host__ __device__ void init(int M, int N, int G_, int c_) { nM = M / BM; nN = N / BM; nwg = nM * nN; G = G_; c = c_; }
    __host__ __device__ bool next(int i, Unit& u) const {
        const long L = (long)i * G + c; if (L >= nwg) return false;
        if (G == 256 && nM == 64 && (nwg & 7) == 0) { u.pm = 8 * (c & 7) + ((c >> 3) & 7); u.pn = 4 * i + (c >> 6); return true; }
        int wgid = (int)L; { const int q = nwg / NXCD, r = nwg % NXCD, xcd = wgid % NXCD, off = wgid / NXCD; wgid = (xcd < r ? xcd * (q + 1) : r * (q + 1) + (xcd - r) * q) + off; }
        const int nig = WGM * nN, gid = wgid / nig, fm = gid * WGM, gsz = (nM - fm) < WGM ? (nM - fm) : WGM;
        u.pm = fm + ((wgid % nig) % gsz); u.pn = (wgid % nig) / gsz; return true;
    }
    __device__ __forceinline__ void a_ready(const Unit&) const {}
    __device__ __forceinline__ void done(const Unit&) const {}
};

typedef float f32x2_cv __attribute__((ext_vector_type(2))); typedef __bf16 bf16x2_cv __attribute__((ext_vector_type(2)));
__device__ __forceinline__ unsigned cvt_pk_bf16(float lo, float hi) { const f32x2_cv v = {lo, hi}; const bf16x2_cv b = __builtin_convertvector(v, bf16x2_cv); return __builtin_bit_cast(unsigned, b); }
typedef float f32x2 __attribute__((ext_vector_type(2)));
__device__ __forceinline__ u32x4 pack8(const f32x4 a, const f32x4 b) { u32x4 w; w.x = cvt_pk_bf16(a[0], a[1]); w.y = cvt_pk_bf16(a[2], a[3]); w.z = cvt_pk_bf16(b[0], b[1]); w.w = cvt_pk_bf16(b[2], b[3]); return w; }
__device__ __forceinline__ float bf_lo(unsigned w) { return __builtin_bit_cast(float, w << 16); }
__device__ __forceinline__ float bf_hi(unsigned w) { return __builtin_bit_cast(float, w & 0xffff0000u); }
__device__ __forceinline__ void load_rstd(float (&rs)[2][4], const float* rowss, int pm, int wr, int fr, int fq) {
#pragma unroll
    for (int ai = 0; ai < 2; ++ai)
#pragma unroll
        for (int m = 0; m < 4; ++m) { const int row = pm * BM + ai * HALF + wr * 64 + m * 16 + fr;
            const f32x4 p = *(const f32x4*)(rowss + (size_t)row * 16 + fq * 4); float s = (p[0] + p[1]) + (p[2] + p[3]);
            s += __shfl_xor(s, 16); s += __shfl_xor(s, 32); rs[ai][m] = __builtin_amdgcn_rsqf(s * (1.0f / DMODEL) + RMS_EPS); }
}
constexpr int RSTAB_OFF = 147456 - 4096 + 2048;
__device__ __forceinline__ void get_rstd(float (&rs)[2][4], const float* rowss, PG8_LAS const float* tab, int tab_pm, int pm, int wr, int fr, int fq) {
    if (pm == tab_pm) {
#pragma unroll
        for (int ai = 0; ai < 2; ++ai)
#pragma unroll
            for (int m = 0; m < 4; ++m) rs[ai][m] = tab[ai * HALF + wr * 64 + m * 16 + fr];
    } else load_rstd(rs, rowss, pm, wr, fr, fq);
}
__device__ __forceinline__ void rstd_table(PG8_LAS float* tab, const float* rowss, int pm) {
    const int t = threadIdx.x;
    if (t < BM) { const float* p = rowss + (size_t)(pm * BM + t) * 16; const f32x4 a = *(const f32x4*)p, b = *(const f32x4*)(p + 4), c = *(const f32x4*)(p + 8), d = *(const f32x4*)(p + 12);
        const float s = ((a[0] + a[1]) + (a[2] + a[3])) + ((b[0] + b[1]) + (b[2] + b[3])) + ((c[0] + c[1]) + (c[2] + c[3])) + ((d[0] + d[1]) + (d[2] + d[3]));
        tab[t] = __builtin_amdgcn_rsqf(s * (1.0f / DMODEL) + RMS_EPS); }
    __syncthreads();
}
struct EpiSwiglu {
    static constexpr bool PERM = true, AFTER_DRAIN = false;
    bf16_t* U; const float* rowss; PG8_LAS const float* tab; int tab_pm;
    __device__ __forceinline__ void operator()(const f32x4 (&acc)[2][2][4][2], const Unit& u, int wr, int wc, int fr, int fq) const {
        float rs[2][4]; get_rstd(rs, rowss, tab, tab_pm, u.pm, wr, fr, fq);
        const int col0 = u.pn * 128 + wc * 32 + 8 * fq;
#pragma unroll
        for (int ai = 0; ai < 2; ++ai)
#pragma unroll
            for (int m = 0; m < 4; ++m) { const int row = u.pm * BM + ai * HALF + wr * 64 + m * 16 + fr; const float r = rs[ai][m], rn = -LOG2E * r, r2 = r * r; f32x4 o[2];
#pragma unroll
                for (int n = 0; n < 2; ++n) { const f32x4 t = acc[ai][0][m][n] * rn, p = acc[ai][0][m][n] * acc[ai][1][m][n];
#pragma unroll
                    for (int e = 0; e < 4; ++e) { const float sg = __builtin_amdgcn_rcpf(1.0f + __builtin_amdgcn_exp2f(t[e])); o[n][e] = p[e] * (r2 * sg); } }
                *(u32x4*)(U + (size_t)row * DFF + col0) = pack8(o[0], o[1]); }
    }
};
template <bool RES_BF16, bool OUT_F32> struct EpiResid {
    static constexpr bool PERM = true, AFTER_DRAIN = false;
    const void* res; void* out; float* rowss; float scale;
    __device__ __forceinline__ void operator()(const f32x4 (&acc)[2][2][4][2], const Unit& u, int wr, int wc, int fr, int fq) const {
        const size_t off0 = (size_t)(u.pm * BM + wr * 64 + fr) * DMODEL + u.pn * BM + wc * 32 + 8 * fq;
        u32x4 rb[2][4][2];
        if (RES_BF16) {
#pragma unroll
            for (int ai = 0; ai < 2; ++ai)
#pragma unroll
                for (int m = 0; m < 4; ++m)
#pragma unroll
                    for (int bj = 0; bj < 2; ++bj) rb[ai][m][bj] = *(const u32x4*)((const bf16_t*)res + off0 + (size_t)(ai * HALF + m * 16) * DMODEL + bj * HALF);
        }
#pragma unroll
        for (int ai = 0; ai < 2; ++ai) {
            f32x4 rf[4][2][2];
            if (!RES_BF16) {
#pragma unroll
                for (int m = 0; m < 4; ++m)
#pragma unroll
                    for (int bj = 0; bj < 2; ++bj) { const float* p = (const float*)res + off0 + (size_t)(ai * HALF + m * 16) * DMODEL + bj * HALF; rf[m][bj][0] = *(const f32x4*)p; rf[m][bj][1] = *(const f32x4*)(p + 4); }
            }
#pragma unroll
            for (int m = 0; m < 4; ++m) { const int row = u.pm * BM + ai * HALF + wr * 64 + m * 16 + fr; float ss = 0.f;
#pragma unroll
                for (int bj = 0; bj < 2; ++bj) { const size_t off = off0 + (size_t)(ai * HALF + m * 16) * DMODEL + bj * HALF;
                    f32x4 r0, r1;
                    if (RES_BF16) { const u32x4 t = rb[ai][m][bj]; r0 = (f32x4){bf_lo(t.x), bf_hi(t.x), bf_lo(t.y), bf_hi(t.y)}; r1 = (f32x4){bf_lo(t.z), bf_hi(t.z), bf_lo(t.w), bf_hi(t.w)}; }
                    else { r0 = rf[m][bj][0]; r1 = rf[m][bj][1]; }
                    const f32x4 o0 = r0 + acc[ai][bj][m][0] * scale, o1 = r1 + acc[ai][bj][m][1] * scale;
                    if (OUT_F32) { *(f32x4*)((float*)out + off) = o0; *(f32x4*)((float*)out + off + 4) = o1; }
                    else *(u32x4*)((bf16_t*)out + off) = pack8(o0, o1);
                    ss += (o0[0] * o0[0] + o0[1] * o0[1]) + (o0[2] * o0[2] + o0[3] * o0[3]) + (o1[0] * o1[0] + o1[1] * o1[1]) + (o1[2] * o1[2] + o1[3] * o1[3]); }
                if (rowss) { ss += __shfl_xor(ss, 16); ss += __shfl_xor(ss, 32); if (fq == 0) rowss[(size_t)row * 16 + u.pn * 4 + wc] = ss; } }
        }
    }
};
struct EpiResidNorm {
    static constexpr bool PERM = true, AFTER_DRAIN = true;
    const bf16_t* res; float* out; float* rowss; const float* gfin; float scale; XcdBarrier xbar;
    __device__ __forceinline__ void fused(f32x4 (&acc)[2][2][4][2], const Unit& u, int wr, int wc, int fr, int fq, PG8_LAS unsigned char* lds, int wid, int lane) const {
        const size_t off0 = (size_t)(u.pm * BM + wr * 64 + fr) * DMODEL + u.pn * BM + wc * 32 + 8 * fq;
        u32x4 rb[2][4][2];
#pragma unroll
        for (int ai = 0; ai < 2; ++ai)
#pragma unroll
            for (int m = 0; m < 4; ++m)
#pragma unroll
                for (int bj = 0; bj < 2; ++bj) rb[ai][m][bj] = *(const u32x4*)(res + off0 + (size_t)(ai * HALF + m * 16) * DMODEL + bj * HALF);
#pragma unroll
        for (int ai = 0; ai < 2; ++ai)
#pragma unroll
            for (int m = 0; m < 4; ++m) { const int row = u.pm * BM + ai * HALF + wr * 64 + m * 16 + fr; float ss = 0.f;
#pragma unroll
                for (int bj = 0; bj < 2; ++bj) { const u32x4 t = rb[ai][m][bj];
                    const f32x4 o0 = (f32x4){bf_lo(t.x), bf_hi(t.x), bf_lo(t.y), bf_hi(t.y)} + acc[ai][bj][m][0] * scale, o1 = (f32x4){bf_lo(t.z), bf_hi(t.z), bf_lo(t.w), bf_hi(t.w)} + acc[ai][bj][m][1] * scale;
                    acc[ai][bj][m][0] = o0; acc[ai][bj][m][1] = o1;
                    ss += (o0[0] * o0[0] + o0[1] * o0[1]) + (o0[2] * o0[2] + o0[3] * o0[3]) + (o1[0] * o1[0] + o1[1] * o1[1]) + (o1[2] * o1[2] + o1[3] * o1[3]); }
                ss += __shfl_xor(ss, 16); ss += __shfl_xor(ss, 32); if (fq == 0) rowss[(size_t)row * 16 + u.pn * 4 + wc] = ss; }
        xcd_barrier(xbar);
        if (TS_A >= 0 && blockIdx.x == 0) { if (threadIdx.x == 0) ((PG8_LAS unsigned long long*)(lds + 147456 - 4096 + 1024))[9] = __builtin_amdgcn_s_memrealtime(); __syncthreads(); }
        float rs[2][4]; load_rstd(rs, rowss, u.pm, wr, fr, fq);
        f32x4 gv[2][2];
#pragma unroll
        for (int bj = 0; bj < 2; ++bj)
#pragma unroll
            for (int n = 0; n < 2; ++n) gv[bj][n] = *(const f32x4*)(gfin + u.pn * BM + bj * HALF + wc * 32 + 8 * fq + 4 * n);
#pragma unroll
        for (int ai = 0; ai < 2; ++ai)
#pragma unroll
            for (int m = 0; m < 4; ++m)
#pragma unroll
                for (int bj = 0; bj < 2; ++bj) { float* p = out + off0 + (size_t)(ai * HALF + m * 16) * DMODEL + bj * HALF; const float r = rs[ai][m];
                    f32x4 q0 = acc[ai][bj][m][0] * r * gv[bj][0], q1 = acc[ai][bj][m][1] * r * gv[bj][1];
                    if (TS_A >= 0 && blockIdx.x == 0) {
                        const PG8_LAS unsigned long long* ts = (const PG8_LAS unsigned long long*)(lds + 147456 - 4096 + 1024);
                        const unsigned nper = (unsigned)((ts[TS_B < 0 ? 0 : TS_B] - ts[TS_A < 0 ? 0 : TS_A]) * 64ull / 100ull); const unsigned base = (unsigned)((((ai * 4 + m) * 2 + bj) * 8) * 512 + threadIdx.x);
#pragma unroll
                        for (int c = 0; c < 4; ++c) { if (base + c * 512 < nper) q0[c] += 0.05f; if (base + (4 + c) * 512 < nper) q1[c] += 0.05f; } }
                    *(f32x4*)p = q0; *(f32x4*)(p + 4) = q1; }
    }
};
struct EpiInProj {
    static constexpr bool PERM = true, AFTER_DRAIN = false;
    unsigned char* ws; const float* bgate; PG8_LAS const float* tab; int tab_pm;
    __device__ __forceinline__ void operator()(const f32x4 (&acc)[2][2][4][2], const Unit& u, int wr, int wc, int fr, int fq) const {
        float rs[2][4]; get_rstd(rs, (const float*)(ws + WSO_RSS), tab, tab_pm, u.pm, wr, fr, fq);
        const int pn = u.pn;
        bf16_t *qsb = (bf16_t*)(ws + WSO_QSB), *ksb = (bf16_t*)(ws + WSO_KSB), *vsb = (bf16_t*)(ws + WSO_VSB), *qdl = (bf16_t*)(ws + WSO_QDL), *kdl = (bf16_t*)(ws + WSO_KDL), *vdl = (bf16_t*)(ws + WSO_VDL), *gates = (bf16_t*)(ws + WSO_GATES);
        const float* ropec = (const float*)(ws + WSO_ROPE); const float* ropes = ropec + SEQ * 32;
        if (pn < 6 || pn == 10) {
            bf16_t* base; int pitch, c0; float sc = 1.f;
            if (pn < 2) { base = qsb; pitch = SBW; c0 = pn * 256; sc = QSCALE; } else if (pn < 4) { base = ksb; pitch = SBW; c0 = (pn - 2) * 256; }
            else if (pn < 6) { base = vsb; pitch = SBW; c0 = (pn - 4) * 256; } else { base = vdl; pitch = DKVW; c0 = 0; }
#pragma unroll
            for (int ai = 0; ai < 2; ++ai)
#pragma unroll
                for (int m = 0; m < 4; ++m) { const int row = u.pm * BM + ai * HALF + wr * 64 + m * 16 + fr; const float r = rs[ai][m] * sc;
#pragma unroll
                    for (int bj = 0; bj < 2; ++bj) *(u32x4*)(base + (size_t)row * pitch + c0 + bj * HALF + wc * 32 + 8 * fq) = pack8(acc[ai][bj][m][0] * r, acc[ai][bj][m][1] * r); }
        } else if (pn < 10) {
            bf16_t* base; int pitch, c0; float sc = 1.f;
            if (pn < 9) { base = qdl; pitch = DQW; c0 = (pn - 6) * 256; sc = QSCALE; } else { base = kdl; pitch = DKVW; c0 = 0; }
#pragma unroll
            for (int am = 0; am < 4; ++am) { const int ai = am >> 1, m0 = (am & 1) * 2;
                f32x4 cs[2][2], sn[2][2];
#pragma unroll
                for (int mm = 0; mm < 2; ++mm) { const int pos = (u.pm * BM + ai * HALF + wr * 64 + (m0 + mm) * 16 + fr) & (SEQ - 1);
#pragma unroll
                    for (int n = 0; n < 2; ++n) { cs[mm][n] = *(const f32x4*)(ropec + pos * 32 + 8 * fq + 4 * n); sn[mm][n] = *(const f32x4*)(ropes + pos * 32 + 8 * fq + 4 * n); } }
#pragma unroll
                for (int mm = 0; mm < 2; ++mm) { const int m = m0 + mm, row = u.pm * BM + ai * HALF + wr * 64 + m * 16 + fr; const float r = rs[ai][m] * sc;
                    f32x4 o1[2], o2[2];
#pragma unroll
                    for (int n = 0; n < 2; ++n) { const f32x4 t1 = acc[ai][0][m][n] * r, t2 = acc[ai][1][m][n] * r; o1[n] = t1 * cs[mm][n] - t2 * sn[mm][n]; o2[n] = t2 * cs[mm][n] + t1 * sn[mm][n]; }
                    bf16_t* rp = base + (size_t)row * pitch + c0 + wc * 64 + 8 * fq;
                    *(u32x4*)(rp) = pack8(o1[0], o1[1]); *(u32x4*)(rp + 32) = pack8(o2[0], o2[1]); }
                asm volatile("" ::: "memory");
            }
        } else {
            const int c0 = (pn - 11) * 256;
            f32x4 bv[2][2];
#pragma unroll
            for (int bj = 0; bj < 2; ++bj)
#pragma unroll
                for (int n = 0; n < 2; ++n) bv[bj][n] = *(const f32x4*)(bgate + c0 + bj * HALF + wc * 32 + 8 * fq + 4 * n) * (-LOG2E);
#pragma unroll
            for (int ai = 0; ai < 2; ++ai)
#pragma unroll
                for (int m = 0; m < 4; ++m) { const int row = u.pm * BM + ai * HALF + wr * 64 + m * 16 + fr; const float rn = -LOG2E * rs[ai][m];
#pragma unroll
                    for (int bj = 0; bj < 2; ++bj) { const int col = c0 + bj * HALF + wc * 32 + 8 * fq; f32x4 o[2];
#pragma unroll
                        for (int n = 0; n < 2; ++n) { const f32x4 v = acc[ai][bj][m][n] * rn + bv[bj][n];
#pragma unroll
                            for (int e = 0; e < 4; ++e) o[n][e] = __builtin_amdgcn_rcpf(1.0f + __builtin_amdgcn_exp2f(v[e])); }
                        *(u32x4*)(gates + (size_t)row * 2048 + col) = pack8(o[0], o[1]); } }
        }
    }
};
template <bool SECOND> struct EpiGate {
    static constexpr bool PERM = true, AFTER_DRAIN = false;
    bf16_t* mbuf; const bf16_t* gates; int goff;
    __device__ __forceinline__ void operator()(const f32x4 (&acc)[2][2][4][2], const Unit& u, int wr, int wc, int fr, int fq) const {
        const int row0 = u.pm * BM + wr * 64 + fr, col0 = u.pn * BM + wc * 32 + 8 * fq;
        u32x4 gq[2][4][2];
        if (!SECOND) {
#pragma unroll
            for (int ai = 0; ai < 2; ++ai)
#pragma unroll
                for (int m = 0; m < 4; ++m)
#pragma unroll
                    for (int bj = 0; bj < 2; ++bj) gq[ai][m][bj] = *(const u32x4*)(gates + (size_t)(row0 + ai * HALF + m * 16) * 2048 + goff + col0 + bj * HALF);
        }
#pragma unroll
        for (int ai = 0; ai < 2; ++ai) {
            u32x4 tq[4][2];
            if (SECOND) {
#pragma unroll
                for (int m = 0; m < 4; ++m)
#pragma unroll
                    for (int bj = 0; bj < 2; ++bj) { gq[ai][m][bj] = *(const u32x4*)(gates + (size_t)(row0 + ai * HALF + m * 16) * 2048 + goff + col0 + bj * HALF); tq[m][bj] = *(const u32x4*)(mbuf + (size_t)(row0 + ai * HALF + m * 16) * DMODEL + col0 + bj * HALF); }
            }
#pragma unroll
            for (int m = 0; m < 4; ++m)
#pragma unroll
                for (int bj = 0; bj < 2; ++bj) { const int row = row0 + ai * HALF + m * 16, col = col0 + bj * HALF; const u32x4 g = gq[ai][m][bj];
                    f32x4 o0 = acc[ai][bj][m][0] * (f32x4){bf_lo(g.x), bf_hi(g.x), bf_lo(g.y), bf_hi(g.y)}, o1 = acc[ai][bj][m][1] * (f32x4){bf_lo(g.z), bf_hi(g.z), bf_lo(g.w), bf_hi(g.w)};
                    if (SECOND) { const u32x4 t = tq[m][bj]; o0 += (f32x4){bf_lo(t.x), bf_hi(t.x), bf_lo(t.y), bf_hi(t.y)}; o1 += (f32x4){bf_lo(t.z), bf_hi(t.z), bf_lo(t.w), bf_hi(t.w)}; }
                    *(u32x4*)(mbuf + (size_t)row * DMODEL + col) = pack8(o0, o1); }
        }
    }
};

template <class Epi, class Sched, bool ALIGN_EPI = false, bool SP2 = false>
__device__ __forceinline__ void gemm_phase(PG8_LAS unsigned char* lds, const Gemm g, const Sched& S, const Epi& E) {
    const int tid = threadIdx.x, wid = __builtin_amdgcn_readfirstlane(tid >> 6), lane = tid & 63, wr = wid >> 2, wc = wid & 3, fr = lane & 15, fq = lane >> 4;
    const int K = g.K, nt = K / BK;
    unsigned voffA[2], voffB[2];
#pragma unroll
    for (int i = 0; i < 2; ++i) { int R, C; stage_rc(tid * 16 + i * 8192, R, C); const int Rb = Epi::PERM ? ((R & ~31) + perm32(R & 31)) : R;
        voffA[i] = (unsigned)(R * K + C) * 2u; voffB[i] = (unsigned)(Rb * K + C) * 2u; }
    const size_t kstep = (size_t)(BK * 2);
    const size_t hstep = (size_t)HALF * K * 2;
    const size_t tstep = 2 * hstep;
    const unsigned ldsw = (unsigned)wid * 1024u;
    const int aoff = lds_byte(wr * 64 + fr, fq * 8), boff = lds_byte(wc * 32 + fr, fq * 8);
#define PG8_SA(b, h) (((b) * 2 + (h)) * HTB)
#define PG8_SB(b, h) ((4 + (b) * 2 + (h)) * HTB)
#define PG8_STAGE(bufoff, gbase, voff) do { _Pragma("unroll") for (int _i = 0; _i < 2; ++_i) \
        __builtin_amdgcn_global_load_lds((const unsigned*)((const char*)(gbase) + (voff)[_i]), (PG8_LAS unsigned*)(lds + (bufoff) + ldsw + _i * 8192), 16, 0, 0); } while (0)
#define PG8_LDA(dst, b, h) do { _Pragma("unroll") for (int m = 0; m < 4; ++m) _Pragma("unroll") for (int k = 0; k < 2; ++k) dst[m][k] = *(const PG8_LAS bf16x8*)(lds + PG8_SA(b, h) + aoff + m * 2048 + k * 1024); } while (0)
#define PG8_LDB(dst, b, h) do { _Pragma("unroll") for (int n = 0; n < 2; ++n) _Pragma("unroll") for (int k = 0; k < 2; ++k) dst[n][k] = *(const PG8_LAS bf16x8*)(lds + PG8_SB(b, h) + boff + n * 2048 + k * 1024); } while (0)
#define PG8_MMA(ai, bj, At, Bt) do { __builtin_amdgcn_s_setprio(1); _Pragma("unroll") for (int m = 0; m < 4; ++m) _Pragma("unroll") for (int n = 0; n < 2; ++n) _Pragma("unroll") for (int k = 0; k < 2; ++k) \
        acc[ai][bj][m][n] = __builtin_amdgcn_mfma_f32_16x16x32_bf16(Bt[n][k], At[m][k], acc[ai][bj][m][n], 0, 0, 0); __builtin_amdgcn_s_setprio(0); } while (0)
#define PG8_WAIT_V(n) asm volatile("s_waitcnt vmcnt(" #n ")" ::: "memory")
#define PG8_WAIT_L(n) asm volatile("s_waitcnt lgkmcnt(" #n ")" ::: "memory")
#define PG8_BAR __builtin_amdgcn_s_barrier()
#define PG8_SCHED __builtin_amdgcn_sched_barrier(0)
    Unit cur, nxt; int ui = 0;
    if (!S.next(0, cur)) return;
    f32x4 acc[2][2][4][2];
#pragma unroll
    for (int a = 0; a < 2; ++a)
#pragma unroll
        for (int b = 0; b < 2; ++b)
#pragma unroll
            for (int m = 0; m < 4; ++m)
#pragma unroll
                for (int n = 0; n < 2; ++n) acc[a][b][m][n] = (f32x4){0.f, 0.f, 0.f, 0.f};
    bf16x8 At[4][2], B0[2][2], B1[2][2];
    const char* cA = (const char*)g.A + (size_t)cur.pm * tstep; const char* cB = (const char*)g.Bt + (size_t)cur.pn * tstep;
    S.a_ready(cur);
    if constexpr (SP2) {
        PG8_STAGE(PG8_SB(0, 0), cB, voffB); PG8_STAGE(PG8_SB(0, 1), cB + hstep, voffB); PG8_STAGE(PG8_SA(0, 0), cA, voffA); PG8_STAGE(PG8_SA(0, 1), cA + hstep, voffA);
        if (wr == 1) PG8_BAR;
        PG8_WAIT_V(2); PG8_BAR;
        PG8_STAGE(PG8_SB(1, 0), cB + kstep, voffB); PG8_STAGE(PG8_SA(1, 0), cA + kstep, voffA); PG8_STAGE(PG8_SB(1, 1), cB + hstep + kstep, voffB);
        PG8_WAIT_V(6); PG8_BAR;
    } else {
        PG8_STAGE(PG8_SB(0, 0), cB, voffB); PG8_STAGE(PG8_SA(0, 0), cA, voffA); PG8_STAGE(PG8_SB(0, 1), cB + hstep, voffB); PG8_STAGE(PG8_SA(0, 1), cA + hstep, voffA);
        if (wr == 1) PG8_BAR;
        PG8_WAIT_V(4); PG8_BAR;
        PG8_STAGE(PG8_SB(1, 0), cB + kstep, voffB); PG8_STAGE(PG8_SA(1, 0), cA + kstep, voffA); PG8_STAGE(PG8_SB(1, 1), cB + hstep + kstep, voffB);
        PG8_WAIT_V(6); PG8_BAR;
    }
    for (;;) {
        const bool has_next = S.next(ui + 1, nxt);
        const char* nA = has_next ? (const char*)g.A + (size_t)nxt.pm * tstep : cA; const char* nB = has_next ? (const char*)g.Bt + (size_t)nxt.pn * tstep : cB;
        for (int t = 0; t < nt; t += 2) {
            const bool last = (t == nt - 2);
            const char* a1 = cA + (size_t)(t + 1) * kstep;
            const char* a2 = last ? nA : cA + (size_t)(t + 2) * kstep; const char* b2 = last ? nB : cB + (size_t)(t + 2) * kstep;
            const char* a3 = a2 + kstep; const char* b3 = b2 + kstep;
            if (last && has_next) S.a_ready(nxt);
            if constexpr (SP2) {
            PG8_LDB(B0, 0, 0); PG8_LDB(B1, 0, 1); PG8_SCHED; PG8_LDA(At, 0, 0); PG8_STAGE(PG8_SA(1, 1), a1 + hstep, voffA);
            PG8_WAIT_V(8); PG8_WAIT_L(0); PG8_BAR; PG8_MMA(0, 0, At, B0); PG8_MMA(0, 1, At, B1); PG8_BAR; PG8_SCHED;
            PG8_LDA(At, 0, 1); PG8_STAGE(PG8_SB(0, 0), b2, voffB); PG8_STAGE(PG8_SB(0, 1), b2 + hstep, voffB); PG8_STAGE(PG8_SA(0, 0), a2, voffA);
            PG8_WAIT_V(8); PG8_WAIT_L(0); PG8_BAR; PG8_MMA(1, 0, At, B0); PG8_MMA(1, 1, At, B1); PG8_BAR; PG8_SCHED;
            PG8_LDB(B0, 1, 0); PG8_LDB(B1, 1, 1); PG8_SCHED; PG8_LDA(At, 1, 0); PG8_STAGE(PG8_SA(0, 1), a2 + hstep, voffA);
            PG8_WAIT_V(8); PG8_WAIT_L(0); PG8_BAR; PG8_MMA(0, 0, At, B0); PG8_MMA(0, 1, At, B1); PG8_BAR; PG8_SCHED;
            PG8_LDA(At, 1, 1); PG8_STAGE(PG8_SB(1, 0), b3, voffB); PG8_STAGE(PG8_SB(1, 1), b3 + hstep, voffB); PG8_STAGE(PG8_SA(1, 0), a3, voffA);
            PG8_WAIT_V(8); PG8_WAIT_L(0); PG8_BAR; PG8_MMA(1, 0, At, B0); PG8_MMA(1, 1, At, B1); PG8_BAR; PG8_SCHED;
            } else {
            PG8_LDB(B0, 0, 0); PG8_SCHED; PG8_LDA(At, 0, 0); PG8_STAGE(PG8_SA(1, 1), a1 + hstep, voffA);
            PG8_WAIT_L(8); PG8_BAR; PG8_WAIT_L(0); PG8_MMA(0, 0, At, B0); PG8_BAR; PG8_SCHED;
            PG8_LDB(B1, 0, 1); PG8_STAGE(PG8_SB(0, 0), b2, voffB);
            PG8_BAR; PG8_WAIT_L(0); PG8_MMA(0, 1, At, B1); PG8_BAR;
            PG8_LDA(At, 0, 1); PG8_STAGE(PG8_SA(0, 0), a2, voffA);
            PG8_BAR; PG8_WAIT_L(0); PG8_MMA(1, 0, At, B0); PG8_BAR; PG8_SCHED;
            PG8_STAGE(PG8_SB(0, 1), b2 + hstep, voffB);
            PG8_WAIT_V(6); PG8_BAR; PG8_MMA(1, 1, At, B1); PG8_BAR;
            PG8_LDB(B0, 1, 0); PG8_SCHED; PG8_LDA(At, 1, 0); PG8_STAGE(PG8_SA(0, 1), a2 + hstep, voffA);
            PG8_WAIT_L(8); PG8_BAR; PG8_WAIT_L(0); PG8_MMA(0, 0, At, B0); PG8_BAR; PG8_SCHED;
            PG8_LDB(B1, 1, 1); PG8_STAGE(PG8_SB(1, 0), b3, voffB);
            PG8_BAR; PG8_WAIT_L(0); PG8_MMA(0, 1, At, B1); PG8_BAR;
            PG8_LDA(At, 1, 1); PG8_STAGE(PG8_SA(1, 0), a3, voffA);
            PG8_BAR; PG8_WAIT_L(0); PG8_MMA(1, 0, At, B0); PG8_BAR; PG8_SCHED;
            PG8_STAGE(PG8_SB(1, 1), b3 + hstep, voffB);
            PG8_WAIT_V(6); PG8_BAR; PG8_MMA(1, 1, At, B1); PG8_BAR;
            }
        }
        if constexpr (ALIGN_EPI) { if (wr == 0) PG8_BAR; }
        if constexpr (!Epi::AFTER_DRAIN) { E(acc, cur, wr, wc, fr, fq); S.done(cur); }
        if (!has_next) break;
#pragma unroll
        for (int a = 0; a < 2; ++a)
#pragma unroll
            for (int b = 0; b < 2; ++b)
#pragma unroll
                for (int m = 0; m < 4; ++m)
#pragma unroll
                    for (int n = 0; n < 2; ++n) acc[a][b][m][n] = (f32x4){0.f, 0.f, 0.f, 0.f};
        cur = nxt; cA = nA; cB = nB; ++ui;
        if constexpr (ALIGN_EPI) { if (wr == 1) PG8_BAR; }
    }
    PG8_WAIT_V(0);
    if constexpr (!ALIGN_EPI) { if (wr == 0) PG8_BAR; }
    PG8_BAR;
    if constexpr (Epi::AFTER_DRAIN) { E.fused(acc, cur, wr, wc, fr, fq, lds, wid, lane); S.done(cur); }
#undef PG8_SA
#undef PG8_SB
#undef PG8_STAGE
#undef PG8_LDA
#undef PG8_LDB
#undef PG8_MMA
#undef PG8_WAIT_V
#undef PG8_WAIT_L
#undef PG8_BAR
#undef PG8_SCHED
}
}
typedef unsigned short bf16;
typedef unsigned v4u __attribute__((ext_vector_type(4)));
typedef float f32x4 __attribute__((ext_vector_type(4)));
typedef short s16x8 __attribute__((ext_vector_type(8)));
typedef float f32x16 __attribute__((ext_vector_type(16)));
#define LDS_WAIT() asm volatile("s_waitcnt lgkmcnt(0)" ::: "memory")
constexpr int NWAVES = 8, NTHREADS = 512;
constexpr int RING_BYTES = 131072, LDS_BYTES = 147456, LDSCTL_OFF = LDS_BYTES - 4096;
constexpr size_t MiB = 1u << 20, HMiB = 1u << 19;
constexpr size_t WS_W13A = 0, WS_W2A = 11 * MiB, WS_WIN = 33 * HMiB, WS_WSB = 26 * MiB, WS_WDIL = 27 * MiB, WS_WO = 55 * HMiB, WS_W13B = 59 * HMiB, WS_W2B = 81 * HMiB;
constexpr size_t WS_ROPE = 46 * MiB, WS_RSS = 48 * MiB, WS_YDL = 49 * MiB, WS_XB = 57 * MiB;
constexpr size_t WS_U = 89 * MiB;
constexpr size_t WS_QSB = 89 * MiB, WS_KSB = 105 * MiB, WS_VSB = 121 * MiB, WS_QDL = 137 * MiB, WS_KDL = 161 * MiB, WS_VDL = 169 * MiB, WS_GATES = 177 * MiB;
constexpr size_t WS_MBUF = WS_KSB;
constexpr size_t WS_LSE = 241 * MiB, WS_CTL = 242 * MiB, WS_END = 243 * MiB;
static_assert(WS_ROPE == WSO_ROPE && WS_RSS == WSO_RSS && WS_QSB == WSO_QSB && WS_KSB == WSO_KSB && WS_VSB == WSO_VSB && WS_QDL == WSO_QDL && WS_KDL == WSO_KDL && WS_VDL == WSO_VDL && WS_GATES == WSO_GATES, "d_ws map");
static_assert(WS_W13A + (size_t)2 * DFF * DMODEL * 2 == WS_W2A && WS_W2A + (size_t)DMODEL * DFF * 2 == WS_WIN && WS_WIN + (size_t)INW * DMODEL * 2 == WS_WSB && WS_WO + (size_t)DMODEL * DMODEL * 2 == WS_W13B
              && WS_W13B + (size_t)2 * DFF * DMODEL * 2 == WS_W2B && WS_W2B + (size_t)DMODEL * DFF * 2 == WS_ROPE && WS_U + (size_t)MTOK * DFF * 2 == WS_GATES && WS_GATES + (size_t)MTOK * 2048 * 2 == WS_LSE, "d_ws map");

__device__ __forceinline__ unsigned f2bf(float f) { unsigned u = __builtin_bit_cast(unsigned, f); return (u + 0x7fffu + ((u >> 16) & 1u)) >> 16; }
__device__ __forceinline__ unsigned pk2(float lo, float hi) { return f2bf(lo) | (f2bf(hi) << 16); }
__device__ __forceinline__ float wave_sum(float v) {
#pragma unroll
    for (int o = 1; o < 64; o <<= 1) v += __shfl_xor(v, o);
    return v;
}
__device__ __forceinline__ void transpose_item(const float* W, int N, const float* g, bf16* WT, int Kd, int k0, int n0, int drow0, LAS float* scr, int lane) {
    const float* wp = W + (size_t)(k0 + (lane >> 5)) * N + n0 + (lane & 31);
    float v[32];
#pragma unroll
    for (int i = 0; i < 32; ++i) v[i] = __builtin_nontemporal_load(wp + (size_t)(2 * i) * N);
    const int c = lane & 7;
    f32x4 g0 = {1.f, 1.f, 1.f, 1.f}, g1 = g0;
    if (g) { g0 = *(const f32x4*)(g + k0 + 8 * c); g1 = *(const f32x4*)(g + k0 + 8 * c + 4); }
#pragma unroll
    for (int i = 0; i < 32; ++i) scr[(2 * i + (lane >> 5)) * 33 + (lane & 31)] = v[i];
    LDS_WAIT(); asm volatile("" ::: "memory");
#pragma unroll
    for (int j = 0; j < 4; ++j) { const int n = (lane >> 3) + 8 * j; const LAS float* s = scr + (8 * c) * 33 + n;
        v4u o; o.x = pk2(s[0 * 33] * g0[0], s[1 * 33] * g0[1]); o.y = pk2(s[2 * 33] * g0[2], s[3 * 33] * g0[3]); o.z = pk2(s[4 * 33] * g1[0], s[5 * 33] * g1[1]); o.w = pk2(s[6 * 33] * g1[2], s[7 * 33] * g1[3]);
        *(v4u*)(WT + (size_t)(drow0 + n) * Kd + k0 + 8 * c) = o; }
    LDS_WAIT(); asm volatile("" ::: "memory");
}
struct Args { const float* in[16]; float* out; unsigned char* ws; int ph_lo, ph_hi, coop, pad; };
enum { IN_X = 0, IN_G_FFN1, IN_W1_A, IN_W3_A, IN_W2_A, IN_G_MIX, IN_W_IN, IN_B_GATE, IN_W_SB_OUT, IN_W_DIL_OUT, IN_W_O, IN_G_FFN2, IN_W1_B, IN_W3_B, IN_W2_B, IN_G_FINAL };
constexpr int I_UP = (DMODEL / 64) * (DFF / 32), I_DN = (DFF / 64) * (DMODEL / 32), I_IN = (DMODEL / 64) * (INW / 32), I_SB = (SBW / 64) * (DMODEL / 32), I_DL = (DKVW / 64) * (DMODEL / 32), I_O = (DMODEL / 64) * (DMODEL / 32);
constexpr int CV_A = 0, CV_B = 2 * I_UP, CV_C = CV_B + I_DN + I_IN, CV_D = CV_C + I_SB + I_DL + I_O, CV_END = CV_D + 2 * I_UP + I_DN;
constexpr int CV_D1 = CV_D + 1024, CV_E = CV_D + 2 * I_UP;
__device__ __forceinline__ void convert_range(const Args& P, LAS float* scr, int first, int last, int worker, int nworkers, int lane) {
    unsigned char* ws = P.ws;
    for (int it = first + worker; it < last; it += nworkers) {
        int r = it;
        if (r < CV_B || r >= CV_D) {
            const bool second = r >= CV_D; if (second) r -= CV_D;
            if (r < 2 * I_UP) { const int which = r / I_UP; r -= which * I_UP; const int nblk = DFF / 32, k0 = 64 * (r / nblk), n0 = 32 * (r % nblk);
                const float* W = P.in[(second ? IN_W1_B : IN_W1_A) + which];
                transpose_item(W, DFF, P.in[second ? IN_G_FFN2 : IN_G_FFN1], (bf16*)(ws + (second ? WS_W13B : WS_W13A)), DMODEL, k0, n0, 256 * (n0 / 128) + 128 * which + (n0 % 128), scr, lane); continue; }
            r -= 2 * I_UP; { const int nblk = DMODEL / 32, k0 = 64 * (r / nblk), n0 = 32 * (r % nblk); transpose_item(P.in[IN_W2_B], DMODEL, nullptr, (bf16*)(ws + WS_W2B), DFF, k0, n0, n0, scr, lane); continue; }
        }
        r -= CV_B;
        if (r < I_DN) { const int nblk = DMODEL / 32, k0 = 64 * (r / nblk), n0 = 32 * (r % nblk); transpose_item(P.in[IN_W2_A], DMODEL, nullptr, (bf16*)(ws + WS_W2A), DFF, k0, n0, n0, scr, lane); continue; }
        r -= I_DN;
        if (r < I_IN) { const int nblk = INW / 32, k0 = 64 * (r / nblk), n0 = 32 * (r % nblk); int drow = n0;
            if (n0 >= 1536 && n0 < 2560) { const int a0 = n0 & 255; drow = (n0 & ~255) + 128 * ((a0 >> 5) & 1) + 32 * (a0 >> 6); }
            transpose_item(P.in[IN_W_IN], INW, P.in[IN_G_MIX], (bf16*)(ws + WS_WIN), DMODEL, k0, n0, drow, scr, lane); continue; }
        r -= I_IN;
        if (r < I_SB) { const int nblk = DMODEL / 32, k0 = 64 * (r / nblk), n0 = 32 * (r % nblk); transpose_item(P.in[IN_W_SB_OUT], DMODEL, nullptr, (bf16*)(ws + WS_WSB), SBW, k0, n0, n0, scr, lane); continue; }
        r -= I_SB;
        if (r < I_DL) { const int nblk = DMODEL / 32, k0 = 64 * (r / nblk), n0 = 32 * (r % nblk); transpose_item(P.in[IN_W_DIL_OUT], DMODEL, nullptr, (bf16*)(ws + WS_WDIL), DKVW, k0, n0, n0, scr, lane); continue; }
        r -= I_DL;
        { const int nblk = DMODEL / 32, k0 = 64 * (r / nblk), n0 = 32 * (r % nblk); transpose_item(P.in[IN_W_O], DMODEL, nullptr, (bf16*)(ws + WS_WO), DMODEL, k0, n0, n0, scr, lane); }
    }
}
__device__ __forceinline__ void p0_prologue(const Args& P, LAS unsigned char* lds, int gw, int NGW, int wave, int lane, bool defer) {
    LAS float* scr = (LAS float*)(lds + wave * 16384);
    unsigned char* ws = P.ws;
#ifndef P0_DUP
#define P0_DUP 0
#endif
    for (int dup_ = 0; dup_ < (P0_DUP == 1 ? 2 : 1); ++dup_)
    convert_range(P, scr, CV_A, defer ? CV_B : CV_END, gw, NGW, lane);
    bf16* xb = (bf16*)(ws + WS_XB); float* rowss = (float*)(ws + WS_RSS);
    for (int dup_ = 0; dup_ < (P0_DUP == 2 ? 2 : 1); ++dup_)
    for (int m0 = gw; m0 < MTOK; m0 += 8 * NGW) {
        f32x4 v[8][4];
#pragma unroll
        for (int q = 0; q < 8; ++q) { const int mq = (m0 + q * NGW < MTOK) ? m0 + q * NGW : m0; const f32x4* xr = (const f32x4*)(P.in[IN_X] + (size_t)mq * DMODEL) + lane;
#pragma unroll
            for (int j = 0; j < 4; ++j) v[q][j] = __builtin_nontemporal_load(xr + 64 * j); }
#pragma unroll
        for (int q = 0; q < 8; ++q) { const int m = m0 + q * NGW; float s = 0.f;
            if (m < MTOK) {
#pragma unroll
                for (int j = 0; j < 4; ++j) s += (v[q][j].x * v[q][j].x + v[q][j].y * v[q][j].y) + (v[q][j].z * v[q][j].z + v[q][j].w * v[q][j].w);
                s = wave_sum(s);
                unsigned long long* o8 = (unsigned long long*)(xb + (size_t)m * DMODEL) + lane;
#pragma unroll
                for (int j = 0; j < 4; ++j) o8[64 * j] = (unsigned long long)pk2(v[q][j].x, v[q][j].y) | ((unsigned long long)pk2(v[q][j].z, v[q][j].w) << 32);
                if (lane < 16) rowss[(size_t)m * 16 + lane] = lane == 0 ? s : 0.f; } }
    }
    float* ropec = (float*)(ws + WS_ROPE); float* ropes = ropec + SEQ * 32;
    for (int dup_ = 0; dup_ < (P0_DUP == 3 ? 2 : 1); ++dup_)
    for (int e = gw * 64 + lane; e < SEQ * 32; e += NGW * 64) { const int pos = e >> 5, i = e & 31;
        const float invf = powf(10000.0f, -(float)i / 32.0f); const float ang = (float)pos * invf;
        double rev = (double)ang * 0.15915494309189535; rev -= __builtin_rint(rev); const float fr = (float)rev;
        ropec[e] = __builtin_amdgcn_cosf(fr); ropes[e] = __builtin_amdgcn_sinf(fr); }
}
__device__ __forceinline__ int crow(int r, int hi) { return (r & 3) + 8 * (r >> 2) + 4 * hi; }
__device__ __forceinline__ unsigned cvtpk(float lo, float hi) { return pg8::cvt_pk_bf16(lo, hi); }
__device__ __forceinline__ s16x8 pack_p(const f32x16& p, int c) { v4u w; w.x = cvtpk(p[8 * c + 0], p[8 * c + 1]); w.y = cvtpk(p[8 * c + 2], p[8 * c + 3]); w.z = cvtpk(p[8 * c + 4], p[8 * c + 5]); w.w = cvtpk(p[8 * c + 6], p[8 * c + 7]); return __builtin_bit_cast(s16x8, w); }
constexpr int VT_PITCH = 96, VT_BYTES = 32 * VT_PITCH * 2;
typedef short v4i16_t __attribute__((ext_vector_type(4)));
struct VRegs { s16x8 t[4]; };
__device__ __forceinline__ void vload(VRegs& v, const bf16* vsrc  , unsigned rstride, int lane) {
    const bf16* p = vsrc + (size_t)((unsigned)(lane >> 1) * rstride + (unsigned)(lane & 1) * 32u);
#pragma unroll
    for (int i = 0; i < 4; ++i) v.t[i] = *(const s16x8*)(p + 8 * i);
}
__device__ __forceinline__ void vfrags(s16x8 (&vf)[2][2], const VRegs& v, LAS bf16* vt, int lane) {
    const int r32 = lane & 31, hi = lane >> 5;
    asm volatile("s_waitcnt lgkmcnt(0)" ::: "memory");
    LAS bf16* wp = vt + (lane >> 1) * VT_PITCH + (lane & 1) * 32;
#pragma unroll
    for (int i = 0; i < 4; ++i) *(LAS s16x8*)(wp + 8 * i) = v.t[i];
    asm volatile("s_waitcnt lgkmcnt(0)" ::: "memory");
    const int grp = lane >> 4, q = (lane & 15) >> 2, p = lane & 3;
    const LAS bf16* rp = vt + (4 * (grp >> 1) + q) * VT_PITCH + 16 * (grp & 1) + 4 * p;
#pragma unroll
    for (int c = 0; c < 2; ++c)
#pragma unroll
        for (int db = 0; db < 2; ++db) {
            const v4i16_t lo = __builtin_amdgcn_ds_read_tr16_b64_v4i16((LAS v4i16_t*)(rp + (16 * c) * VT_PITCH + 32 * db)), hi8 = __builtin_amdgcn_ds_read_tr16_b64_v4i16((LAS v4i16_t*)(rp + (16 * c + 8) * VT_PITCH + 32 * db));
            vf[db][c] = (s16x8){lo[0], lo[1], lo[2], lo[3], hi8[0], hi8[1], hi8[2], hi8[3]}; }
}
__device__ __forceinline__ void store_o(bf16* ob  , unsigned rstride, const f32x16& o0, const f32x16& o1, LAS bf16* vt, int lane) {
    const int r32 = lane & 31, hi = lane >> 5;
    asm volatile("s_waitcnt lgkmcnt(0)" ::: "memory");
    LAS bf16* wp = vt + 4 * hi * VT_PITCH + r32;
#pragma unroll
    for (int r = 0; r < 16; ++r) { const int row = (r & 3) + 8 * (r >> 2); const unsigned w = cvtpk(o0[r], o1[r]); wp[row * VT_PITCH] = (bf16)(w & 0xffffu); wp[row * VT_PITCH + 32] = (bf16)(w >> 16); }
    asm volatile("s_waitcnt lgkmcnt(0)" ::: "memory");
    const LAS bf16* rp = vt + (lane >> 1) * VT_PITCH + (lane & 1) * 32;
    bf16* gp = ob + (size_t)((unsigned)(lane >> 1) * rstride + (unsigned)(lane & 1) * 32u);
#pragma unroll
    for (int i = 0; i < 4; ++i) *(s16x8*)(gp + 8 * i) = *(const LAS s16x8*)(rp + 8 * i);
}
__device__ __forceinline__ void kload(s16x8 (&kf)[4], const bf16* ksrc  , unsigned rstride, int lane) {
    const bf16* p = ksrc + (size_t)((unsigned)(lane & 31) * rstride + (unsigned)(lane >> 5) * 8u);
#pragma unroll
    for (int d0 = 0; d0 < 4; ++d0) kf[d0] = *(const s16x8*)(p + 16 * d0);
}
__device__ __forceinline__ void sb_item(int item, const bf16* QO, bf16* OUT, const bf16* K, const bf16* V, LAS bf16* vt, int lane) {
    const int r32 = lane & 31, hi = lane >> 5;
    const int qb = 255 - (item & 255), h = (item >> 8) & 7, b = item >> 11;
    const int t0 = qb * 32; const size_t rowb = (size_t)b * SEQ;
    s16x8 qr[4]; kload(qr, QO + (rowb + t0) * SBW + h * 64, SBW, lane);
    const bf16* Kh = K + rowb * SBW + h * 64; const bf16* Vh = V + rowb * SBW + h * 64;
    f32x16 o0 = {}, o1 = {}; float carry = 1.f;
    s16x8 kn[4]; VRegs vn; kload(kn, Kh + (size_t)t0 * SBW, SBW, lane); vload(vn, Vh + (size_t)t0 * SBW, SBW, lane);
    for (int kb = t0; kb >= 0; kb -= 32) {
        s16x8 kf[4]; VRegs vc;
#pragma unroll
        for (int d0 = 0; d0 < 4; ++d0) { kf[d0] = kn[d0]; vc.t[d0] = vn.t[d0]; }
        if (kb >= 32) { kload(kn, Kh + (size_t)(kb - 32) * SBW, SBW, lane); vload(vn, Vh + (size_t)(kb - 32) * SBW, SBW, lane); }
        f32x16 s = {};
#pragma unroll
        for (int d0 = 0; d0 < 4; ++d0) s = __builtin_amdgcn_mfma_f32_32x32x16_bf16(kf[d0], qr[d0], s, 0, 0, 0);
        float be[16], nb[16];
#pragma unroll
        for (int r = 0; r < 16; ++r) { const float e = __builtin_amdgcn_exp2f(-__builtin_fmaxf(s[r], -126.0f)); const float rc = __builtin_amdgcn_rcpf(1.0f + e); be[r] = rc; nb[r] = e * rc; }
        if (kb == t0) {
#pragma unroll
            for (int r = 0; r < 16; ++r) if (!(crow(r, hi) < r32)) { be[r] = 0.f; nb[r] = 1.f; }
        }
        float tot[4], pg[4];
#pragma unroll
        for (int g = 0; g < 4; ++g) { const float gs = (nb[4 * g] * nb[4 * g + 1]) * (nb[4 * g + 2] * nb[4 * g + 3]); pg[g] = __shfl_xor(gs, 32); tot[g] = gs * pg[g]; }
        float T[4]; T[3] = 1.f; T[2] = tot[3]; T[1] = T[2] * tot[2]; T[0] = T[1] * tot[1]; const float total = T[0] * tot[0];
        f32x16 a;
#pragma unroll
        for (int g = 0; g < 4; ++g) { const float w3 = carry * T[g] * (hi == 0 ? pg[g] : 1.f), w2 = w3 * nb[4 * g + 3], w1 = w2 * nb[4 * g + 2], w0 = w1 * nb[4 * g + 1];
            a[4 * g + 0] = be[4 * g + 0] * w0; a[4 * g + 1] = be[4 * g + 1] * w1; a[4 * g + 2] = be[4 * g + 2] * w2; a[4 * g + 3] = be[4 * g + 3] * w3; }
        carry *= total;
        const s16x8 pa0 = pack_p(a, 0), pa1 = pack_p(a, 1);
        s16x8 vf[2][2]; vfrags(vf, vc, vt, lane);
        o0 = __builtin_amdgcn_mfma_f32_32x32x16_bf16(pa0, vf[0][0], o0, 0, 0, 0); o0 = __builtin_amdgcn_mfma_f32_32x32x16_bf16(pa1, vf[0][1], o0, 0, 0, 0);
        o1 = __builtin_amdgcn_mfma_f32_32x32x16_bf16(pa0, vf[1][0], o1, 0, 0, 0); o1 = __builtin_amdgcn_mfma_f32_32x32x16_bf16(pa1, vf[1][1], o1, 0, 0, 0);
        if (__all(carry < 1e-37f)) break;
    }
    store_o(OUT + (rowb + t0) * SBW + h * 64, SBW, o0, o1, vt, lane);
}
__device__ __forceinline__ void dl_item(int item, const bf16* QO, bf16* OUT, const bf16* K, const bf16* V, float* LSE, LAS bf16* vt, int lane) {
    const int r32 = lane & 31, hi = lane >> 5;
    const int g = item >> 11, rem = item & 2047, b = rem >> 10, j = (rem >> 8) & 3, blk = rem & 255;
    const int dsh = 2 * g, dil = 1 << dsh, nsb = 256 >> dsh, rr = blk / nsb, i0 = (blk % nsb) * 32;
    const size_t rowb = (size_t)b * SEQ + rr;
    const unsigned qstride = (unsigned)dil * DQW, kstride = (unsigned)dil * DKVW;
    const size_t qoff = (rowb + (size_t)dil * i0) * DQW + (g * 4 + j) * 64; const bf16* Qb = QO + qoff;
    s16x8 qr[4]; kload(qr, Qb, qstride, lane);
    const bf16* Kh = K + rowb * DKVW + j * 64; const bf16* Vh = V + rowb * DKVW + j * 64;
    f32x16 sc[5]; float mx = -INFINITY; const float flim = (float)(r32 - 4 * hi);
    const int n0 = i0 >= 128 ? 0 : (128 - i0) >> 5;
    s16x8 kf[5][4];
#pragma unroll
    for (int n = 0; n < 5; ++n) { const int nn = n < n0 ? n0 : n; kload(kf[n], Kh + (size_t)(i0 - 128 + 32 * nn) * kstride, kstride, lane); }
    VRegs vn; vload(vn, Vh + (size_t)(i0 - 128 + 32 * n0) * kstride, kstride, lane);
#pragma unroll
    for (int n = 0; n < 5; ++n) {
        f32x16 s = {};
#pragma unroll
        for (int d0 = 0; d0 < 4; ++d0) s = __builtin_amdgcn_mfma_f32_32x32x16_bf16(kf[n][d0], qr[d0], s, 0, 0, 0);
        const float dead = n < n0 ? -INFINITY : INFINITY;
#pragma unroll
        for (int r = 0; r < 16; ++r) {
            if (n == 0) s[r] = __builtin_fminf(s[r], ((float)((r & 3) + 8 * (r >> 2)) - flim + 0.5f) * 6e38f);
            if (n == 4) s[r] = __builtin_fminf(s[r], (flim - (float)((r & 3) + 8 * (r >> 2)) + 0.5f) * 6e38f);
            if (n < 4) s[r] = __builtin_fminf(s[r], dead);
            mx = __builtin_fmaxf(mx, s[r]); }
        sc[n] = s;
    }
    mx = __builtin_fmaxf(mx, __shfl_xor(mx, 32));
    float l = 0.f;
#pragma unroll
    for (int n = 0; n < 5; ++n)
#pragma unroll
        for (int r = 0; r < 16; ++r) { const float p = __builtin_amdgcn_exp2f(sc[n][r] - mx); sc[n][r] = p; l += p; }
    l += __shfl_xor(l, 32);
    const float inv = 1.0f / l;
    f32x16 o0 = {}, o1 = {};
#pragma unroll
    for (int n = 0; n < 5; ++n) {
        if (n >= n0) {
            VRegs vc;
#pragma unroll
            for (int q = 0; q < 4; ++q) vc.t[q] = vn.t[q];
            if (n < 4) vload(vn, Vh + (size_t)(i0 - 128 + 32 * (n + 1)) * kstride, kstride, lane);
            f32x16 p = sc[n] * inv;
            const s16x8 pa0 = pack_p(p, 0), pa1 = pack_p(p, 1);
            s16x8 vf[2][2]; vfrags(vf, vc, vt, lane);
            o0 = __builtin_amdgcn_mfma_f32_32x32x16_bf16(pa0, vf[0][0], o0, 0, 0, 0); o0 = __builtin_amdgcn_mfma_f32_32x32x16_bf16(pa1, vf[0][1], o0, 0, 0, 0);
            o1 = __builtin_amdgcn_mfma_f32_32x32x16_bf16(pa0, vf[1][0], o1, 0, 0, 0); o1 = __builtin_amdgcn_mfma_f32_32x32x16_bf16(pa1, vf[1][1], o1, 0, 0, 0);
        }
    }
    store_o(OUT + qoff, qstride, o0, o1, vt, lane);
    if (hi == 0) LSE[((size_t)g * MTOK + rowb + (size_t)dil * (i0 + r32)) * 4 + j] = mx + __builtin_amdgcn_logf(l);
}
__device__ __forceinline__ void combine_rows(int pm, const bf16* O, const float* LSE, bf16* YDL, int tid) {
#pragma unroll 4
    for (int k = 0; k < 16; ++k) { const int c = tid + NTHREADS * k, row = pm * 256 + (c >> 5), cc = c & 31, j = cc >> 3;
        const float l0 = LSE[((size_t)0 * MTOK + row) * 4 + j], l1 = LSE[((size_t)1 * MTOK + row) * 4 + j], l2 = LSE[((size_t)2 * MTOK + row) * 4 + j];
        const float M = __builtin_fmaxf(l0, __builtin_fmaxf(l1, l2)); float w0 = __builtin_amdgcn_exp2f(l0 - M), w1 = __builtin_amdgcn_exp2f(l1 - M), w2 = __builtin_amdgcn_exp2f(l2 - M);
        const float inv = 1.0f / (w0 + w1 + w2); w0 *= inv; w1 *= inv; w2 *= inv;
        const bf16* op = O + (size_t)row * DQW + cc * 8;
        const v4u a = *(const v4u*)op, bq = *(const v4u*)(op + 256), cq = *(const v4u*)(op + 512);
        v4u o;
#define CMB(x) pk2(w0 * pg8::bf_lo(a.x) + w1 * pg8::bf_lo(bq.x) + w2 * pg8::bf_lo(cq.x), w0 * pg8::bf_hi(a.x) + w1 * pg8::bf_hi(bq.x) + w2 * pg8::bf_hi(cq.x))
        o.x = CMB(x); o.y = CMB(y); o.z = CMB(z); o.w = CMB(w);
#undef CMB
        *(v4u*)(YDL + (size_t)row * DKVW + cc * 8) = o; }
}


__device__ __forceinline__ int mk_lane() { int t = (int)threadIdx.x; asm volatile("" : "+v"(t)); return t & 63; }
constexpr int NPHASES = 10;
__global__ void __launch_bounds__(NTHREADS, 2) mk_fwd(Args args) {
    extern __shared__ __attribute__((aligned(16))) unsigned char lds_raw[];
    LAS unsigned char* lds = (LAS unsigned char*)lds_raw;
    cg::grid_group grid = cg::this_grid();
    const int tid = threadIdx.x, wave = __builtin_amdgcn_readfirstlane(tid >> 6);
#define lane mk_lane()
    const int G = gridDim.x, gw = blockIdx.x * NWAVES + wave, NGW = G * NWAVES;
    unsigned char* ws = args.ws;
#define xb ((bf16*)(ws + WS_XB))
#define rowss ((float*)(ws + WS_RSS))
#define U ((bf16*)(ws + WS_U))
#define qsb ((bf16*)(ws + WS_QSB))
#define ksb ((bf16*)(ws + WS_KSB))
#define vsb ((bf16*)(ws + WS_VSB))
#define qdl ((bf16*)(ws + WS_QDL))
#define kdl ((bf16*)(ws + WS_KDL))
#define vdl ((bf16*)(ws + WS_VDL))
#define gates ((bf16*)(ws + WS_GATES))
#define mbuf ((bf16*)(ws + WS_MBUF))
#define ydl ((bf16*)(ws + WS_YDL))
#define lse ((float*)(ws + WS_LSE))
    const int lo = args.ph_lo, hi = args.ph_hi;
#ifndef PHMASK
#define PHMASK 0x3ff
#endif
#define IN(k) (((PHMASK >> (k)) & 1) && lo <= (k) && (k) < hi)
#define GBAR() do { if (args.coop) xcd_barrier(xbar); } while (0)
#ifndef DEFER_CVT
#define DEFER_CVT 1
#endif
#ifndef FUSE_FINAL
#define FUSE_FINAL 1
#endif
#define SEAM(k) do { if ((k) == 8 && FUSE_FINAL && args.coop && G == 256) break; if (IN(k) && IN((k) + 1)) { if ((k) == 0 && args.coop == 2) grid.sync(); else GBAR(); } } while (0)
    XcdBarrier xbar; xbar.bar = (unsigned*)(ws + WS_CTL); xbar.x = 0; xbar.st = (volatile LAS unsigned*)(lds + LDSCTL_OFF);
    if (tid < 2) ((LAS unsigned*)(lds + LDSCTL_OFF))[tid] = 0u;
    __syncthreads();
    if (args.coop) xbar = xcd_barrier_post((unsigned*)(ws + WS_CTL), (volatile LAS unsigned*)(lds + LDSCTL_OFF));
    LAS unsigned long long* tstamp = (LAS unsigned long long*)(lds + LDSCTL_OFF + 1024);
#define STAMP(i) do { if (TS_A >= 0 && blockIdx.x == 0 && tid == 0) tstamp[i] = __builtin_amdgcn_s_memrealtime(); } while (0)
    STAMP(0);
#ifndef REPEAT_PH
#define REPEAT_PH -1
#endif
#define REP(k) for (int rep_ = (REPEAT_PH == (k)) ? 0 : 1; rep_ < 2; ++rep_)
#define REPBAR(k) do { if (REPEAT_PH == (k) && rep_ == 0) GBAR(); } while (0)

    const bool defer = DEFER_CVT && args.coop && G == 256;
    if (IN(0)) REP(0) {
        p0_prologue(args, lds, gw, NGW, wave, lane, defer); __syncthreads(); if (REPEAT_PH == 0 && rep_ == 0 && args.coop) GBAR(); }
    SEAM(0); STAMP(1);
#define PBODY1 { pg8::Gemm g{xb, (const bf16*)(ws + WS_W13A), MTOK, 2 * DFF, DMODEL}; pg8::StaticOrder S; S.init(MTOK, 2 * DFF, G, (int)blockIdx.x);         pg8::Unit u0_; int tpm_ = -1; if (S.next(0, u0_)) { tpm_ = u0_.pm; pg8::rstd_table((LAS float*)(lds + pg8::RSTAB_OFF), rowss, tpm_); } pg8::EpiSwiglu E{U, rowss, (LAS const float*)(lds + pg8::RSTAB_OFF), tpm_}; pg8::gemm_phase<pg8::EpiSwiglu, pg8::StaticOrder, true, true>(lds, g, S, E); }
    if (IN(1)) { if (REPEAT_PH == 1) { PBODY1; GBAR(); } PBODY1;
        if (defer && blockIdx.x >= 128) { convert_range(args, (LAS float*)(lds + wave * 16384), CV_B, CV_C, ((int)blockIdx.x - 128) * NWAVES + wave, 128 * NWAVES, lane); } }
    SEAM(1); STAMP(2);
#define PBODY2 { pg8::Gemm g{U, (const bf16*)(ws + WS_W2A), MTOK, DMODEL, DFF}; pg8::StaticOrder S; S.init(MTOK, DMODEL, G, (int)blockIdx.x);         pg8::EpiResid<true, false> E{xb, xb, rowss, 0.5f}; pg8::gemm_phase<pg8::EpiResid<true, false>, pg8::StaticOrder, true, true>    (lds, g, S, E); }
    if (IN(2)) { if (REPEAT_PH == 2) { PBODY2; GBAR(); } PBODY2; }
    SEAM(2); STAMP(3);
#define PBODY3 { pg8::Gemm g{xb, (const bf16*)(ws + WS_WIN), MTOK, INW, DMODEL}; pg8::StaticOrder S; S.init(MTOK, INW, G, (int)blockIdx.x);         pg8::Unit u0_; int tpm_ = -1; if (S.next(0, u0_)) { tpm_ = u0_.pm; pg8::rstd_table((LAS float*)(lds + pg8::RSTAB_OFF), rowss, tpm_); } pg8::EpiInProj E{ws, args.in[7], (LAS const float*)(lds + pg8::RSTAB_OFF), tpm_}; pg8::gemm_phase<pg8::EpiInProj, pg8::StaticOrder, true, true>(lds, g, S, E); }
    if (IN(3)) { if (REPEAT_PH == 3) { PBODY3; GBAR(); } PBODY3;
        if (defer && blockIdx.x >= 192) { convert_range(args, (LAS float*)(lds + wave * 16384), CV_C, CV_D1, ((int)blockIdx.x - 192) * NWAVES + wave, 64 * NWAVES, lane); } }
    SEAM(3); STAMP(4);
    if (IN(4)) REP(4) {
        bf16* osb = (REPEAT_PH == 4 && rep_ == 0) ? (bf16*)(ws + WS_XB) : qsb; bf16* odl = (REPEAT_PH == 4 && rep_ == 0) ? (bf16*)(ws + WS_XB) : qdl;
        constexpr int N_DL = 3 * 2048, N_SB = 2 * 8 * 256; LAS bf16* vt = (LAS bf16*)(lds + wave * 8192); const int lane4 = lane;
        for (int it = gw; it < N_DL + N_SB; it += NGW) {
#ifndef NO_DL
            if (it < N_DL) dl_item(it, qdl, odl, kdl, vdl, lse, vt, lane4);
#endif
#ifndef NO_SB
            if (it >= N_DL) sb_item(it - N_DL, qsb, osb, ksb, vsb, vt, lane4);
#endif
 }
        if (defer && !(REPEAT_PH == 4 && rep_ == 0)) { convert_range(args, (LAS float*)(lds + 65536 + wave * 8448), CV_D1, CV_E, gw, NGW, lane4); }
        REPBAR(4);
    }
    SEAM(4); STAMP(5);
#define PBODY5 { pg8::StaticOrder S; S.init(MTOK, DMODEL, G, (int)blockIdx.x); pg8::Unit u; for (int dup_ = 0; dup_ < (P0_DUP == 5 ? 2 : 1); ++dup_) for (int i = 0; S.next(i, u); ++i) combine_rows(u.pm, qdl, lse, ydl, tid); asm volatile("s_waitcnt vmcnt(0)" ::: "memory"); __syncthreads(); { pg8::Gemm g{qsb, (const bf16*)(ws + WS_WSB), MTOK, DMODEL, SBW}; pg8::EpiGate<false> E{mbuf, gates, 0}; pg8::gemm_phase<pg8::EpiGate<false>, pg8::StaticOrder, true, true>(lds, g, S, E); } asm volatile("s_waitcnt vmcnt(0)" ::: "memory"); __syncthreads(); { pg8::Gemm g{ydl, (const bf16*)(ws + WS_WDIL), MTOK, DMODEL, DKVW}; pg8::EpiGate<true> E{mbuf, gates, DMODEL}; pg8::gemm_phase<pg8::EpiGate<true>, pg8::StaticOrder, true, true>(lds, g, S, E); } }
    if (IN(5)) { if (REPEAT_PH == 5) { PBODY5; GBAR(); } PBODY5; }
    SEAM(5); STAMP(6);
    if (IN(6)) { pg8::Gemm g{mbuf, (const bf16*)(ws + WS_WO), MTOK, DMODEL, DMODEL}; pg8::StaticOrder S; S.init(MTOK, DMODEL, G, (int)blockIdx.x);
        pg8::EpiResid<true, false> E{xb, xb, rowss, 1.0f}; pg8::gemm_phase<pg8::EpiResid<true, false>, pg8::StaticOrder, true, true>(lds, g, S, E); }
    SEAM(6); STAMP(7);
    if (REPEAT_PH == 10) { GBAR(); GBAR(); GBAR(); GBAR(); }
#define PBODY7 { pg8::Gemm g{xb, (const bf16*)(ws + WS_W13B), MTOK, 2 * DFF, DMODEL}; pg8::StaticOrder S; S.init(MTOK, 2 * DFF, G, (int)blockIdx.x);         pg8::Unit u0_; int tpm_ = -1; if (S.next(0, u0_)) { tpm_ = u0_.pm; pg8::rstd_table((LAS float*)(lds + pg8::RSTAB_OFF), rowss, tpm_); } pg8::EpiSwiglu E{U, rowss, (LAS const float*)(lds + pg8::RSTAB_OFF), tpm_}; pg8::gemm_phase<pg8::EpiSwiglu, pg8::StaticOrder, true, true>(lds, g, S, E); }
    if (IN(7)) { if (REPEAT_PH == 7) { PBODY7; GBAR(); } PBODY7;
        if (defer && blockIdx.x >= 128) { convert_range(args, (LAS float*)(lds + wave * 16384), CV_E, CV_END, ((int)blockIdx.x - 128) * NWAVES + wave, 128 * NWAVES, lane); } }
    SEAM(7); STAMP(8);
    if (IN(8)) { pg8::Gemm g{U, (const bf16*)(ws + WS_W2B), MTOK, DMODEL, DFF}; pg8::StaticOrder S; S.init(MTOK, DMODEL, G, (int)blockIdx.x);
        if (FUSE_FINAL && args.coop && G == 256) { pg8::EpiResidNorm E{xb, args.out, rowss, args.in[15], 0.5f, xbar}; pg8::gemm_phase<pg8::EpiResidNorm, pg8::StaticOrder, false, true>(lds, g, S, E); }
        else { pg8::EpiResid<true, true> E{xb, args.out, nullptr, 0.5f}; pg8::gemm_phase<pg8::EpiResid<true, true>, pg8::StaticOrder, true, true>(lds, g, S, E); } }
    SEAM(8); STAMP(9);
    if (IN(9) && !(FUSE_FINAL && args.coop && G == 256)) {
        if (TS_A >= 0) __syncthreads();
        const int lane9 = lane;
        const f32x4* gr = (const f32x4*)args.in[15] + lane9; f32x4 gv[4];
#pragma unroll
        for (int j = 0; j < 4; ++j) gv[j] = gr[64 * j];
        for (int m0 = gw; m0 < MTOK; m0 += 4 * NGW) {
            f32x4 v[4][4];
#pragma unroll
            for (int q = 0; q < 4; ++q) { const f32x4* xr = (const f32x4*)(args.out + (size_t)(m0 + q * NGW) * DMODEL) + lane9;
#pragma unroll
                for (int j = 0; j < 4; ++j) v[q][j] = xr[64 * j]; }
#pragma unroll
            for (int q = 0; q < 4; ++q) { const int m = m0 + q * NGW; f32x4* xr = (f32x4*)(args.out + (size_t)m * DMODEL) + lane9; float s = 0.f;
#pragma unroll
                for (int j = 0; j < 4; ++j) s += (v[q][j].x * v[q][j].x + v[q][j].y * v[q][j].y) + (v[q][j].z * v[q][j].z + v[q][j].w * v[q][j].w);
                const float rstd = 1.0f / sqrtf(wave_sum(s) * (1.0f / DMODEL) + RMS_EPS);
#pragma unroll
                for (int j = 0; j < 4; ++j) { f32x4 o = v[q][j] * rstd * gv[j];
                    if (TS_A >= 0 && blockIdx.x == 0) {
                        const unsigned nper = (unsigned)((tstamp[TS_B] - tstamp[TS_A]) * 64ull / 100ull); const unsigned base = (unsigned)(((m / NGW) * 8 + wave) * 1024 + 256 * j + 4 * lane9);
#pragma unroll
                        for (int c = 0; c < 4; ++c) if (base + c < nper) o[c] += 0.05f; }
                    xr[64 * j] = o; } }
        }
    }
#undef IN
#undef SEAM
#undef lane
#undef xb
#undef rowss
#undef U
#undef qsb
#undef ksb
#undef vsb
#undef qdl
#undef kdl
#undef vdl
#undef gates
#undef mbuf
#undef ydl
#undef lse
}

#ifndef MK_SINGLE
#define MK_SINGLE 1
#endif
extern "C" void kernel_launch(void* const* d_in, const int* in_sizes, int n_in, void* d_out, int out_size, void* d_ws, size_t ws_size, hipStream_t stream) {
    static int grid = 0;
    if (grid == 0) {
        if (n_in != 16 || in_sizes[0] != MTOK * DMODEL || out_size != MTOK * DMODEL || ws_size < WS_END) { fprintf(stderr, "kernel_launch: unexpected shapes (n_in %d, in0 %d, out %d, ws %zu)\n", n_in, n_in > 0 ? in_sizes[0] : -1, out_size, ws_size); grid = -1; return; }
        int dev = 0, cus = 0, per_cu = 0;
        hipGetDevice(&dev); hipDeviceGetAttribute(&cus, hipDeviceAttributeMultiprocessorCount, dev);
        if (hipFuncSetAttribute((const void*)mk_fwd, hipFuncAttributeMaxDynamicSharedMemorySize, LDS_BYTES) != hipSuccess) { fprintf(stderr, "kernel_launch: hipFuncSetAttribute failed\n"); grid = -1; return; }
        if (hipOccupancyMaxActiveBlocksPerMultiprocessor(&per_cu, (const void*)mk_fwd, NTHREADS, LDS_BYTES) != hipSuccess || per_cu < 1) { fprintf(stderr, "kernel_launch: occupancy query says %d\n", per_cu); per_cu = 1; }
        (void)hipGetLastError();
        grid = cus * 1;
    }
    if (grid < 0) return;
    Args a{};
    for (int i = 0; i < 16; ++i) a.in[i] = (const float*)d_in[i];
    a.out = (float*)d_out; a.ws = (unsigned char*)d_ws;
#if MK_SINGLE
    a.ph_lo = 0; a.ph_hi = NPHASES; a.coop = 1;
    if (hipMemsetAsync((unsigned char*)d_ws + WS_CTL, 0, 16384, stream) != hipSuccess) { fprintf(stderr, "kernel_launch: hipMemsetAsync of the barrier words failed\n"); return; }
    void* kargs[] = {&a};
    hipError_t e = hipLaunchCooperativeKernel((const void*)mk_fwd, dim3(grid), dim3(NTHREADS), kargs, LDS_BYTES, stream);
    if (e != hipSuccess) fprintf(stderr, "kernel_launch: cooperative launch failed: %s (grid %d)\n", hipGetErrorString(e), grid);
#else
    for (int p = 0; p < NPHASES; ++p) { a.ph_lo = p; a.ph_hi = p + 1; a.coop = 0; hipLaunchKernelGGL(mk_fwd, dim3(grid), dim3(NTHREADS), LDS_BYTES, stream, a); }
#endif
}
```
